# Optimizing an MI355X kernel written in HIP

```python
import numpy as np
import jax
import jax.numpy as jnp
from jax import lax


D_MODEL = 1024
BATCH = 2
SEQ = 16384
DEPTH = 2
DEC_BATCH = 32
DEC_SEQ = 2048
PAST_LEN = 128

HEAD_DIM = 64
ATTN_SCALE = HEAD_DIM ** -0.5
A_HEADS = D_MODEL // 2 // HEAD_DIM
A_WIDTH = A_HEADS * HEAD_DIM
A_BRANCHES = ((128, 1), (512, 4), (2048, 16))
A_BLOCK = 128
B_GROUPS = 4
B_WINDOWS = (2, 4, 8, 16)
B_WIDTH = D_MODEL // 2
B_GROUP_DIM = B_WIDTH // B_GROUPS
EVEN_IN = 3 * A_WIDTH + B_WIDTH
EVEN_MIX = A_WIDTH + B_WIDTH
C_HEADS = D_MODEL // HEAD_DIM
C_WIDTH = C_HEADS * HEAD_DIM
GRID_W = 64
NA_ROWS = 8
NA_COLS = 16
T5_BUCKETS = 32
T5_MAX_DIST = 1024
D_FF = -(-8 * D_MODEL // (3 * 256)) * 256
N_EVEN = (DEPTH + 1) // 2
N_ODD = DEPTH // 2
NEG = -1e30
EPS = 1e-6

kernel_name = 'hybrid_dilated_pool_natten_encoder'


def rms_norm(x, g):
    xf = x.astype(jnp.float32)
    y = xf * lax.rsqrt(jnp.mean(xf * xf, axis=-1, keepdims=True) + EPS)
    return (y * g.astype(jnp.float32)).astype(x.dtype)


def modulate(h, shift, scale):
    return h * (1 + scale[:, None, :]) + shift[:, None, :]


def t5_bucket(rel):
    nb = T5_BUCKETS // 2
    max_exact = nb // 2
    ret = (rel > 0).astype(np.int32) * nb
    n = np.abs(rel)
    large = max_exact + (np.log(np.maximum(n, 1) / max_exact) / np.log(T5_MAX_DIST / max_exact)
                         * (nb - max_exact)).astype(np.int32)
    large = np.minimum(large, nb - 1)
    return (ret + np.where(n < max_exact, n, large)).astype(np.int32)


def dilated_branch(q, k, v, t5_table, window, dilation):
    b, L, h, dh = q.shape
    r = (window // 2) // dilation
    Ls = L // dilation

    def to_sub(t):
        return t.reshape(b, Ls, dilation, h, dh).transpose(0, 2, 1, 3, 4).reshape(b * dilation, Ls, h, dh)

    qs, ks, vs = to_sub(q), to_sub(k), to_sub(v)
    bq = min(A_BLOCK, Ls)
    nb = -(-Ls // bq)
    Lp = nb * bq
    kw = bq + 2 * r
    qs = jnp.pad(qs, ((0, 0), (0, Lp - Ls), (0, 0), (0, 0)))
    pad_k = ((0, 0), (r, Lp - Ls + r), (0, 0), (0, 0))
    ks = jnp.pad(ks, pad_k)
    vs = jnp.pad(vs, pad_k)
    idx = np.arange(nb)[:, None] * bq + np.arange(kw)[None, :]
    kb = ks[:, idx]
    vb = vs[:, idx]
    qb = qs.reshape(-1, nb, bq, h, dh)
    rel = np.arange(kw)[None, :] - r - np.arange(bq)[:, None]
    kpos = idx - r
    valid = (np.abs(rel) <= r)[None] & ((kpos >= 0) & (kpos < Ls))[:, None, :]
    bias = jnp.transpose(t5_table[t5_bucket(rel * dilation)], (2, 0, 1)).astype(jnp.float32)
    s = jnp.einsum('nbqhd,nbkhd->nbhqk', qb, kb, preferred_element_type=jnp.float32) * ATTN_SCALE + bias
    s = jnp.where(valid[None, :, None], s, NEG)
    m = jnp.max(s, axis=-1)
    p = jnp.exp(s - m[..., None])
    den = jnp.sum(p, axis=-1)
    o = jnp.einsum('nbhqk,nbkhd->nbqhd', p.astype(vb.dtype), vb, preferred_element_type=jnp.float32)
    o = o / jnp.transpose(den, (0, 1, 3, 2))[..., None]
    lse = jnp.transpose(m + jnp.log(den), (0, 1, 3, 2))
    o = o.reshape(b, dilation, Lp, h, dh)[:, :, :Ls].transpose(0, 2, 1, 3, 4).reshape(b, L, h, dh)
    lse = lse.reshape(b, dilation, Lp, h)[:, :, :Ls].transpose(0, 2, 1, 3).reshape(b, L, h)
    return o, lse


def multiscale_pool(u, w_grp, scale):
    b, L, _ = u.shape
    ug = u.reshape(b, L, B_GROUPS, B_GROUP_DIM)
    t = np.arange(L)
    outs = []
    for g, w in enumerate(B_WINDOWS):
        ch = ug[:, :, g].astype(jnp.float32)
        cs = jnp.concatenate([jnp.zeros((b, 1, B_GROUP_DIM), jnp.float32), jnp.cumsum(ch, axis=1)], axis=1)
        lo = np.clip(t - w // 2, 0, L)
        hi = np.clip(t + w // 2, 0, L)
        cnt = (hi - lo).astype(np.float32)
        mean = (cs[:, hi] - cs[:, lo]) / cnt[None, :, None]
        outs.append(mean - ch)
    pooled = jnp.stack(outs, axis=2)
    y = jnp.einsum('blgc,gcd->blgd', pooled, w_grp.astype(jnp.float32))
    y = y * scale.astype(jnp.float32).reshape(B_GROUPS, B_GROUP_DIM)
    return y.reshape(b, L, B_WIDTH).astype(u.dtype)


def even_mixer(h, w_in, w_out, pool_w, pool_scale, t5_table):
    b, L, _ = h.shape
    z = h @ w_in
    q, k, v, u = jnp.split(z, [A_WIDTH, 2 * A_WIDTH, 3 * A_WIDTH], axis=-1)
    q = q.reshape(b, L, A_HEADS, HEAD_DIM)
    k = k.reshape(b, L, A_HEADS, HEAD_DIM)
    v = v.reshape(b, L, A_HEADS, HEAD_DIM)
    outs, lses = [], []
    for window, dilation in A_BRANCHES:
        o, l = dilated_branch(q, k, v, t5_table, window, dilation)
        outs.append(o)
        lses.append(l)
    wts = jax.nn.softmax(jnp.stack(lses, axis=0), axis=0)
    ya = jnp.sum(wts[..., None] * jnp.stack(outs, axis=0), axis=0)
    ya = ya.reshape(b, L, A_WIDTH).astype(h.dtype)
    yb = multiscale_pool(u, pool_w, pool_scale)
    return jnp.concatenate([ya, yb], axis=-1) @ w_out


def neighbourhood_attn(q, k, v, rpb):
    b, L, h, dh = q.shape
    rows = L // GRID_W
    kh = min(NA_ROWS, rows)
    kw = NA_COLS
    qg = q.reshape(b, rows, GRID_W, h, dh)
    kg = k.reshape(b, rows, GRID_W, h, dh)
    vg = v.reshape(b, rows, GRID_W, h, dh)
    c = np.arange(GRID_W)
    cstart = np.clip(c - kw // 2, 0, GRID_W - kw)
    colmask = (c[None, :] >= cstart[:, None]) & (c[None, :] < cstart[:, None] + kw)
    coloff = np.clip(c[None, :] - c[:, None] + NA_COLS - 1, 0, 2 * NA_COLS - 2)

    def row_block(r):
        rs = jnp.clip(r - kh // 2, 0, rows - kh)
        qr = lax.dynamic_index_in_dim(qg, r, axis=1, keepdims=False)
        kr = lax.dynamic_slice_in_dim(kg, rs, kh, axis=1)
        vr = lax.dynamic_slice_in_dim(vg, rs, kh, axis=1)
        rowoff = rs + jnp.arange(kh) - r + (NA_ROWS - 1)
        bias = jnp.take(rpb, rowoff, axis=1)[:, :, coloff]
        bias = jnp.transpose(bias, (0, 2, 1, 3)).astype(jnp.float32)
        s = jnp.einsum('bqhd,bikhd->bhqik', qr, kr, preferred_element_type=jnp.float32) * ATTN_SCALE + bias
        s = jnp.where(colmask[:, None, :], s, NEG)
        p = jax.nn.softmax(s.reshape(b, h, GRID_W, kh * GRID_W), axis=-1)
        return jnp.einsum('bhqn,bnhd->bqhd', p.astype(vr.dtype), vr.reshape(b, kh * GRID_W, h, dh))

    out = lax.map(row_block, jnp.arange(rows))
    return jnp.transpose(out, (1, 0, 2, 3, 4)).reshape(b, L, h * dh)


def odd_mixer(h, w_qkv, w_out, rpb):
    b, L, _ = h.shape
    q, k, v = jnp.split(h @ w_qkv, 3, axis=-1)
    q = q.reshape(b, L, C_HEADS, HEAD_DIM)
    k = k.reshape(b, L, C_HEADS, HEAD_DIM)
    v = v.reshape(b, L, C_HEADS, HEAD_DIM)
    return neighbourhood_attn(q, k, v, rpb).astype(h.dtype) @ w_out


def swiglu(h, w_gate, w_up, w_down):
    return (jax.nn.silu(h @ w_gate) * (h @ w_up)) @ w_down


def setup_inputs(seed: int = 0) -> dict:
    key = jax.random.key(seed)
    ks = jax.random.split(key, 20)
    f32 = jnp.float32

    def nrm(k, shape, s):
        return jax.random.normal(k, shape, f32) * s

    return {
        'x_prompt': nrm(ks[0], (BATCH, SEQ, D_MODEL), 1.0),
        'x_sample': nrm(ks[1], (DEC_BATCH, DEC_SEQ, D_MODEL), 1.0),
        'c_prompt': nrm(ks[2], (BATCH, D_MODEL), 1.0),
        'c_sample': nrm(ks[3], (DEC_BATCH, D_MODEL), 1.0),
        'norm_g': 1.0 + nrm(ks[4], (DEPTH, 4, D_MODEL), 0.05),
        'ada_w': nrm(ks[5], (DEPTH, D_MODEL, 6 * D_MODEL), 0.5 * D_MODEL ** -0.5),
        'ada_b': nrm(ks[6], (DEPTH, 6 * D_MODEL), 0.02),
        'ffn_w_gate': nrm(ks[7], (DEPTH, D_MODEL, D_FF), D_MODEL ** -0.5),
        'ffn_w_up': nrm(ks[8], (DEPTH, D_MODEL, D_FF), D_MODEL ** -0.5),
        'ffn_w_down': nrm(ks[9], (DEPTH, D_FF, D_MODEL), D_FF ** -0.5),
        'even_w_in': nrm(ks[10], (N_EVEN, D_MODEL, EVEN_IN), D_MODEL ** -0.5),
        'even_w_out': nrm(ks[11], (N_EVEN, EVEN_MIX, D_MODEL), EVEN_MIX ** -0.5),
        'pool_w': nrm(ks[12], (N_EVEN, B_GROUPS, B_GROUP_DIM, B_GROUP_DIM), B_GROUP_DIM ** -0.5),
        'pool_scale': 1.0 + nrm(ks[13], (N_EVEN, B_WIDTH), 0.1),
        't5_table': nrm(ks[14], (T5_BUCKETS, A_HEADS), 0.5),
        'odd_w_qkv': nrm(ks[15], (N_ODD, D_MODEL, 3 * C_WIDTH), D_MODEL ** -0.5),
        'odd_w_out': nrm(ks[16], (N_ODD, C_WIDTH, D_MODEL), C_WIDTH ** -0.5),
        'odd_rpb': nrm(ks[17], (N_ODD, C_HEADS, 2 * NA_ROWS - 1, 2 * NA_COLS - 1), 0.5),
    }


def reference(x_prompt, x_sample, c_prompt, c_sample, norm_g, ada_w, ada_b, ffn_w_gate, ffn_w_up,
              ffn_w_down, even_w_in, even_w_out, pool_w, pool_scale, t5_table, odd_w_qkv, odd_w_out, odd_rpb):
    def trunk(x, c):
        for layer in range(DEPTH):
            mod = jax.nn.silu(c) @ ada_w[layer] + ada_b[layer]
            sh1, sc1, g1, sh2, sc2, g2 = jnp.split(mod, 6, axis=-1)
            g = norm_g[layer]
            h = modulate(rms_norm(x, g[0]), sh1, sc1)
            i = layer // 2
            if layer % 2 == 0:
                y = even_mixer(h, even_w_in[i], even_w_out[i], pool_w[i], pool_scale[i], t5_table)
            else:
                y = odd_mixer(h, odd_w_qkv[i], odd_w_out[i], odd_rpb[i])
            x = x + g1[:, None, :] * rms_norm(y, g[1])
            h = modulate(rms_norm(x, g[2]), sh2, sc2)
            y = swiglu(h, ffn_w_gate[layer], ffn_w_up[layer], ffn_w_down[layer])
            x = x + g2[:, None, :] * rms_norm(y, g[3])
        return x

    y_prompt = trunk(x_prompt, c_prompt)
    y_sample = trunk(x_sample, c_sample)
    return (y_prompt, y_sample)
```

```cpp
#include <hip/hip_runtime.h>
#include <hip/hip_cooperative_groups.h>
#include <cstdio>
#include <cstdint>
namespace cg = cooperative_groups;

#ifndef MK_COOP
#define MK_COOP 1
#endif

#define LAS __attribute__((address_space(3)))
typedef unsigned short bf16_t;
typedef short bf16x8 __attribute__((ext_vector_type(8)));
typedef short s16x4 __attribute__((ext_vector_type(4)));
typedef float f32x4 __attribute__((ext_vector_type(4)));
typedef float f32x16 __attribute__((ext_vector_type(16)));
typedef unsigned u32x4 __attribute__((ext_vector_type(4)));
typedef unsigned u32x2 __attribute__((ext_vector_type(2)));

namespace pg8 {
constexpr int BM = 256, BK = 64, HALF = 128, HTB = HALF * BK * 2, STAGE_BYTES = 8 * HTB, NXCD = 8, WGM = 8;
__host__ __device__ __forceinline__ int lds_byte(int r, int c) { const int st = (r >> 4) * 2 + (c >> 5), rr = r & 15, cc = c & 31, ob = rr * 64 + cc * 2; return st * 1024 + (ob ^ (((ob >> 9) & 1) << 5)); }
__host__ __device__ __forceinline__ void stage_rc(int b, int& R, int& C) { const int st = b / 1024, sb = b % 1024, swz = sb ^ (((sb >> 9) & 1) << 5); R = (st >> 1) * 16 + swz / 64; C = (st & 1) * 32 + (swz % 64) / 2; }
__host__ __device__ __forceinline__ int perm32(int rho) { const int n = rho >> 4, i = rho & 15; return 8 * (i >> 2) + 4 * n + (i & 3); }

struct Unit { int pm, pn; };
struct Gemm { const bf16_t* A; const bf16_t* Bt; int M, N, K; };

struct StaticOrder {
    int nM, nN, nwg, G, c;
    __host__ __device__ void init(int M, int N, int G_, int c_) { nM = M / BM; nN = N / BM; nwg = nM * nN; G = G_; c = c_; }
    __host__ __device__ bool next(int i, Unit& u) const {
        const long L = (long)i * G + c; if (L >= nwg) return false;
        int wgid = (int)L; { const int q = nwg / NXCD, r = nwg % NXCD, xcd = wgid % NXCD, off = wgid / NXCD; wgid = (xcd < r ? xcd * (q + 1) : r * (q + 1) + (xcd - r) * q) + off; }
        const int nig = WGM * nN, gid = wgid / nig, fm = gid * WGM, gsz = (nM - fm) < WGM ? (nM - fm) : WGM;
        u.pm = fm + ((wgid % nig) % gsz); u.pn = (wgid % nig) / gsz; return true;
    }
    __device__ __forceinline__ void a_ready(const Unit&) const {}
    __device__ __forceinline__ void done(const Unit&) const {}
};

__device__ __forceinline__ unsigned cvt_pk_bf16(float lo, float hi) { unsigned r; asm volatile("v_cvt_pk_bf16_f32 %0, %1, %2" : "=v"(r) : "v"(lo), "v"(hi)); return r; }

struct EpiBf16 {
    static constexpr bool PERM = true, AFTER_DRAIN = false;
    bf16_t* O; int ldc;
    __device__ __forceinline__ void operator()(const f32x4 (&acc)[2][2][4][2], const Unit& u, int wr, int wc, int fr, int fq) const {
        const int row0 = u.pm * BM + wr * 64 + fr; const int col0 = u.pn * BM + wc * 32 + 8 * fq;
#pragma unroll
        for (int ai = 0; ai < 2; ++ai)
#pragma unroll
            for (int m = 0; m < 4; ++m) { bf16_t* rowp = O + (size_t)(row0 + ai * HALF + m * 16) * ldc + col0;
#pragma unroll
                for (int bj = 0; bj < 2; ++bj) { const f32x4 v0 = acc[ai][bj][m][0], v1 = acc[ai][bj][m][1];
                    u32x4 w; w.x = cvt_pk_bf16(v0[0], v0[1]); w.y = cvt_pk_bf16(v0[2], v0[3]); w.z = cvt_pk_bf16(v1[0], v1[1]); w.w = cvt_pk_bf16(v1[2], v1[3]);
                    *(u32x4*)(rowp + bj * HALF) = w; } }
    }
};
struct EpiSwiglu {
    static constexpr bool PERM = true, AFTER_DRAIN = false;
    bf16_t* O; int ldc;
    __device__ __forceinline__ void operator()(const f32x4 (&acc)[2][2][4][2], const Unit& u, int wr, int wc, int fr, int fq) const {
        const int row0 = u.pm * BM + wr * 64 + fr; const int col0 = u.pn * HALF + wc * 32 + 8 * fq;
#pragma unroll
        for (int ai = 0; ai < 2; ++ai)
#pragma unroll
            for (int m = 0; m < 4; ++m) { bf16_t* rowp = O + (size_t)(row0 + ai * HALF + m * 16) * ldc + col0;
                float r[8];
#pragma unroll
                for (int n = 0; n < 2; ++n)
#pragma unroll
                    for (int j = 0; j < 4; ++j) { const float g = acc[ai][0][m][n][j], up = acc[ai][1][m][n][j]; r[n * 4 + j] = g * __builtin_amdgcn_rcpf(1.0f + __expf(-g)) * up; }
                u32x4 w; w.x = cvt_pk_bf16(r[0], r[1]); w.y = cvt_pk_bf16(r[2], r[3]); w.z = cvt_pk_bf16(r[4], r[5]); w.w = cvt_pk_bf16(r[6], r[7]);
                *(u32x4*)rowp = w; }
    }
};

template <class Epi, class Sched, bool ALIGN_EPI = false, bool SP2 = false>
__device__ __forceinline__ void gemm_phase(LAS unsigned char* lds, const Gemm g, const Sched& S, const Epi& E) {
    const int tid = threadIdx.x, wid = __builtin_amdgcn_readfirstlane(tid >> 6), lane = tid & 63, wr = wid >> 2, wc = wid & 3, fr = lane & 15, fq = lane >> 4;
    const int K = g.K, nt = K / BK;
    unsigned voffA[2], voffB[2];
#pragma unroll
    for (int i = 0; i < 2; ++i) { int R, C; stage_rc(tid * 16 + i * 8192, R, C); const int Rb = Epi::PERM ? ((R & ~31) + perm32(R & 31)) : R;
        voffA[i] = (unsigned)(R * K + C) * 2u; voffB[i] = (unsigned)(Rb * K + C) * 2u; }
    const size_t kstep = (size_t)(BK * 2);
    const size_t hstep = (size_t)HALF * K * 2;
    const size_t tstep = 2 * hstep;
    const unsigned ldsw = (unsigned)wid * 1024u;
    const int aoff = lds_byte(wr * 64 + fr, fq * 8), boff = lds_byte(wc * 32 + fr, fq * 8);
#define PG8_SA(b, h) (((b) * 2 + (h)) * HTB)
#define PG8_SB(b, h) ((4 + (b) * 2 + (h)) * HTB)
#define PG8_STAGE(bufoff, gbase, voff) do { _Pragma("unroll") for (int _i = 0; _i < 2; ++_i) \
        __builtin_amdgcn_global_load_lds((const unsigned*)((const char*)(gbase) + (voff)[_i]), (LAS unsigned*)(lds + (bufoff) + ldsw + _i * 8192), 16, 0, 0); } while (0)
#define PG8_LDA(dst, b, h) do { _Pragma("unroll") for (int m = 0; m < 4; ++m) _Pragma("unroll") for (int k = 0; k < 2; ++k) dst[m][k] = *(const LAS bf16x8*)(lds + PG8_SA(b, h) + aoff + m * 2048 + k * 1024); } while (0)
#define PG8_LDB(dst, b, h) do { _Pragma("unroll") for (int n = 0; n < 2; ++n) _Pragma("unroll") for (int k = 0; k < 2; ++k) dst[n][k] = *(const LAS bf16x8*)(lds + PG8_SB(b, h) + boff + n * 2048 + k * 1024); } while (0)
#define PG8_MMA(ai, bj, At, Bt) do { __builtin_amdgcn_s_setprio(1); _Pragma("unroll") for (int m = 0; m < 4; ++m) _Pragma("unroll") for (int n = 0; n < 2; ++n) _Pragma("unroll") for (int k = 0; k < 2; ++k) \
        acc[ai][bj][m][n] = __builtin_amdgcn_mfma_f32_16x16x32_bf16(Bt[n][k], At[m][k], acc[ai][bj][m][n], 0, 0, 0); __builtin_amdgcn_s_setprio(0); } while (0)
#define PG8_WAIT_V(n) asm volatile("s_waitcnt vmcnt(" #n ")" ::: "memory")
#define PG8_WAIT_L(n) asm volatile("s_waitcnt lgkmcnt(" #n ")" ::: "memory")
#define PG8_BAR __builtin_amdgcn_s_barrier()
#define PG8_SCHED __builtin_amdgcn_sched_barrier(0)
    Unit cur, nxt; int ui = 0;
    if (!S.next(0, cur)) return;
    f32x4 acc[2][2][4][2];
#pragma unroll
    for (int a = 0; a < 2; ++a)
#pragma unroll
        for (int b = 0; b < 2; ++b)
#pragma unroll
            for (int m = 0; m < 4; ++m)
#pragma unroll
                for (int n = 0; n < 2; ++n) acc[a][b][m][n] = (f32x4){0.f, 0.f, 0.f, 0.f};
    bf16x8 At[4][2], B0[2][2], B1[2][2];
    const char* cA = (const char*)g.A + (size_t)cur.pm * tstep; const char* cB = (const char*)g.Bt + (size_t)cur.pn * tstep;
    S.a_ready(cur);
    if constexpr (SP2) {
        PG8_STAGE(PG8_SB(0, 0), cB, voffB); PG8_STAGE(PG8_SB(0, 1), cB + hstep, voffB); PG8_STAGE(PG8_SA(0, 0), cA, voffA); PG8_STAGE(PG8_SA(0, 1), cA + hstep, voffA);
        if (wr == 1) PG8_BAR;
        PG8_WAIT_V(2); PG8_BAR;
        PG8_STAGE(PG8_SB(1, 0), cB + kstep, voffB); PG8_STAGE(PG8_SA(1, 0), cA + kstep, voffA); PG8_STAGE(PG8_SB(1, 1), cB + hstep + kstep, voffB);
        PG8_WAIT_V(6); PG8_BAR;
    } else {
        PG8_STAGE(PG8_SB(0, 0), cB, voffB); PG8_STAGE(PG8_SA(0, 0), cA, voffA); PG8_STAGE(PG8_SB(0, 1), cB + hstep, voffB); PG8_STAGE(PG8_SA(0, 1), cA + hstep, voffA);
        if (wr == 1) PG8_BAR;
        PG8_WAIT_V(4); PG8_BAR;
        PG8_STAGE(PG8_SB(1, 0), cB + kstep, voffB); PG8_STAGE(PG8_SA(1, 0), cA + kstep, voffA); PG8_STAGE(PG8_SB(1, 1), cB + hstep + kstep, voffB);
        PG8_WAIT_V(6); PG8_BAR;
    }
    for (;;) {
        const bool has_next = S.next(ui + 1, nxt);
        const char* nA = has_next ? (const char*)g.A + (size_t)nxt.pm * tstep : cA; const char* nB = has_next ? (const char*)g.Bt + (size_t)nxt.pn * tstep : cB;
        for (int t = 0; t < nt; t += 2) {
            const bool last = (t == nt - 2);
            const char* a1 = cA + (size_t)(t + 1) * kstep;
            const char* a2 = last ? nA : cA + (size_t)(t + 2) * kstep; const char* b2 = last ? nB : cB + (size_t)(t + 2) * kstep;
            const char* a3 = a2 + kstep; const char* b3 = b2 + kstep;
            if (last && has_next) S.a_ready(nxt);
            if constexpr (SP2) {
            PG8_LDB(B0, 0, 0); PG8_LDB(B1, 0, 1); PG8_SCHED; PG8_LDA(At, 0, 0); PG8_STAGE(PG8_SA(1, 1), a1 + hstep, voffA);
            PG8_WAIT_V(8); PG8_WAIT_L(0); PG8_BAR; PG8_MMA(0, 0, At, B0); PG8_MMA(0, 1, At, B1); PG8_BAR; PG8_SCHED;
            PG8_LDA(At, 0, 1); PG8_STAGE(PG8_SB(0, 0), b2, voffB); PG8_STAGE(PG8_SB(0, 1), b2 + hstep, voffB); PG8_STAGE(PG8_SA(0, 0), a2, voffA);
            PG8_WAIT_V(8); PG8_WAIT_L(0); PG8_BAR; PG8_MMA(1, 0, At, B0); PG8_MMA(1, 1, At, B1); PG8_BAR; PG8_SCHED;
            PG8_LDB(B0, 1, 0); PG8_LDB(B1, 1, 1); PG8_SCHED; PG8_LDA(At, 1, 0); PG8_STAGE(PG8_SA(0, 1), a2 + hstep, voffA);
            PG8_WAIT_V(8); PG8_WAIT_L(0); PG8_BAR; PG8_MMA(0, 0, At, B0); PG8_MMA(0, 1, At, B1); PG8_BAR; PG8_SCHED;
            PG8_LDA(At, 1, 1); PG8_STAGE(PG8_SB(1, 0), b3, voffB); PG8_STAGE(PG8_SB(1, 1), b3 + hstep, voffB); PG8_STAGE(PG8_SA(1, 0), a3, voffA);
            PG8_WAIT_V(8); PG8_WAIT_L(0); PG8_BAR; PG8_MMA(1, 0, At, B0); PG8_MMA(1, 1, At, B1); PG8_BAR; PG8_SCHED;
            } else {
            PG8_LDB(B0, 0, 0); PG8_SCHED; PG8_LDA(At, 0, 0); PG8_STAGE(PG8_SA(1, 1), a1 + hstep, voffA);
            PG8_WAIT_L(8); PG8_BAR; PG8_WAIT_L(0); PG8_MMA(0, 0, At, B0); PG8_BAR; PG8_SCHED;
            PG8_LDB(B1, 0, 1); PG8_STAGE(PG8_SB(0, 0), b2, voffB);
            PG8_BAR; PG8_WAIT_L(0); PG8_MMA(0, 1, At, B1); PG8_BAR;
            PG8_LDA(At, 0, 1); PG8_STAGE(PG8_SA(0, 0), a2, voffA);
            PG8_BAR; PG8_WAIT_L(0); PG8_MMA(1, 0, At, B0); PG8_BAR; PG8_SCHED;
            PG8_STAGE(PG8_SB(0, 1), b2 + hstep, voffB);
            PG8_WAIT_V(6); PG8_BAR; PG8_MMA(1, 1, At, B1); PG8_BAR;
            PG8_LDB(B0, 1, 0); PG8_SCHED; PG8_LDA(At, 1, 0); PG8_STAGE(PG8_SA(0, 1), a2 + hstep, voffA);
            PG8_WAIT_L(8); PG8_BAR; PG8_WAIT_L(0); PG8_MMA(0, 0, At, B0); PG8_BAR; PG8_SCHED;
            PG8_LDB(B1, 1, 1); PG8_STAGE(PG8_SB(1, 0), b3, voffB);
            PG8_BAR; PG8_WAIT_L(0); PG8_MMA(0, 1, At, B1); PG8_BAR;
            PG8_LDA(At, 1, 1); PG8_STAGE(PG8_SA(1, 0), a3, voffA);
            PG8_BAR; PG8_WAIT_L(0); PG8_MMA(1, 0, At, B0); PG8_BAR; PG8_SCHED;
            PG8_STAGE(PG8_SB(1, 1), b3 + hstep, voffB);
            PG8_WAIT_V(6); PG8_BAR; PG8_MMA(1, 1, At, B1); PG8_BAR;
            }
        }
        if constexpr (ALIGN_EPI) { if (wr == 0) PG8_BAR; }
        if constexpr (!Epi::AFTER_DRAIN) { E(acc, cur, wr, wc, fr, fq); S.done(cur); }
        if (!has_next) break;
#pragma unroll
        for (int a = 0; a < 2; ++a)
#pragma unroll
            for (int b = 0; b < 2; ++b)
#pragma unroll
                for (int m = 0; m < 4; ++m)
#pragma unroll
                    for (int n = 0; n < 2; ++n) acc[a][b][m][n] = (f32x4){0.f, 0.f, 0.f, 0.f};
        cur = nxt; cA = nA; cB = nB; ++ui;
        if constexpr (ALIGN_EPI) { if (wr == 1) PG8_BAR; }
    }
    PG8_WAIT_V(0);
    if constexpr (!ALIGN_EPI) { if (wr == 0) PG8_BAR; }
    PG8_BAR;
#undef PG8_SA
#undef PG8_SB
#undef PG8_STAGE
#undef PG8_LDA
#undef PG8_LDB
#undef PG8_MMA
#undef PG8_WAIT_V
#undef PG8_WAIT_L
#undef PG8_BAR
#undef PG8_SCHED
}
}

constexpr int NWAVES = 8, NTHR = 512;
constexpr int D = 1024, DFF = 2816, NGU = 2 * DFF;
constexpr int TP = 32768, TSM = 65536, T = TP + TSM, LP = 16384, LSM = 2048, NBATCH = 34;
constexpr int EVEN_IN = 2048, QKV = 3072;
constexpr float EPS = 1e-6f;
constexpr float NEGF = -1e30f;

constexpr size_t MiB = 1u << 20;
constexpr size_t WS_MOD = 0;
constexpr size_t WS_WIN = 2 * MiB;
constexpr size_t WS_WOUT0 = 6 * MiB;
constexpr size_t WS_WQKV = 8 * MiB;
constexpr size_t WS_WOUT1 = 14 * MiB;
constexpr size_t WS_WGU = 16 * MiB;
constexpr size_t WS_WD = 38 * MiB;
constexpr size_t WS_H = 50 * MiB;
constexpr size_t WS_Z = 242 * MiB;
constexpr size_t WS_MX = 818 * MiB;
constexpr size_t WS_OB01 = 626 * MiB;
constexpr size_t WS_OB2 = 50 * MiB;
constexpr size_t WS_LSE = 146 * MiB;
constexpr size_t WS_END = 1010 * MiB;
constexpr int LDS_BYTES = 147456;

__device__ const unsigned char T5B[3][129] = {
{11,11,11,11,11,11,11,11,11,11,11,11,11,11,11,10,10,10,10,10,10,10,10,10,10,10,10,10,10,10,10,10,10,10,10,10,10,10,9,9,9,9,9,9,9,9,9,9,9,9,8,8,8,8,8,8,8,7,6,5,4,3,2,1,0,17,18,19,20,21,22,23,24,24,24,24,24,24,24,25,25,25,25,25,25,25,25,25,25,25,25,26,26,26,26,26,26,26,26,26,26,26,26,26,26,26,26,26,26,26,26,26,26,26,27,27,27,27,27,27,27,27,27,27,27,27,27,27,27},
{13,13,13,13,13,13,13,13,13,13,13,13,13,13,13,13,13,13,13,13,13,13,13,12,12,12,12,12,12,12,12,12,12,12,12,12,12,12,12,12,12,12,11,11,11,11,11,11,11,11,11,11,10,10,10,10,10,10,9,9,9,8,8,4,0,20,24,24,25,25,25,26,26,26,26,26,26,27,27,27,27,27,27,27,27,27,27,28,28,28,28,28,28,28,28,28,28,28,28,28,28,28,28,28,28,28,29,29,29,29,29,29,29,29,29,29,29,29,29,29,29,29,29,29,29,29,29,29,29},
{15,15,15,15,15,15,15,15,15,15,15,15,15,15,15,15,15,15,15,15,15,15,15,15,15,15,15,15,15,15,14,14,14,14,14,14,14,14,14,14,14,14,14,14,14,13,13,13,13,13,13,13,13,13,12,12,12,12,12,11,11,10,10,9,0,25,26,26,27,27,28,28,28,28,28,29,29,29,29,29,29,29,29,29,30,30,30,30,30,30,30,30,30,30,30,30,30,30,30,31,31,31,31,31,31,31,31,31,31,31,31,31,31,31,31,31,31,31,31,31,31,31,31,31,31,31,31,31,31}};

struct Args {
    const float* in[18];
    float* out;
    unsigned char* ws;
    int ph_lo, ph_hi;
};

__device__ __forceinline__ unsigned f2bf(float f) { unsigned u = __builtin_bit_cast(unsigned, f); return (u + 0x7fffu + ((u >> 16) & 1u)) >> 16; }
__device__ __forceinline__ unsigned pk2(float lo, float hi) { return pg8::cvt_pk_bf16(lo, hi); }
__device__ __forceinline__ float bf_lo(unsigned u) { return __builtin_bit_cast(float, u << 16); }
__device__ __forceinline__ float bf_hi(unsigned u) { return __builtin_bit_cast(float, u & 0xffff0000u); }
__device__ __forceinline__ float wave_sum(float v) {
#pragma unroll
    for (int o = 1; o < 64; o <<= 1) v += __shfl_xor(v, o);
    return v;
}
__device__ __forceinline__ int batch_of(int m) { return m < TP ? (m >> 14) : 2 + ((m - TP) >> 11); }

__device__ __forceinline__ void transpose_item(const float* W, int ldw, int k0, int n0, bf16_t* WT, int ldt, int wt_row0, int wt_k0, LAS float* scr, int lane) {
#pragma unroll 8
    for (int i = 0; i < 32; ++i) { const int kk = 2 * i + (lane >> 5); scr[kk * 33 + (lane & 31)] = W[(size_t)(k0 + kk) * ldw + n0 + (lane & 31)]; }
    asm volatile("s_waitcnt lgkmcnt(0)" ::: "memory");
    const int c = lane & 7;
#pragma unroll
    for (int j = 0; j < 4; ++j) { const int n = (lane >> 3) + 8 * j; const LAS float* s = scr + (8 * c) * 33 + n;
        u32x4 o; o.x = pk2(s[0 * 33], s[1 * 33]); o.y = pk2(s[2 * 33], s[3 * 33]); o.z = pk2(s[4 * 33], s[5 * 33]); o.w = pk2(s[6 * 33], s[7 * 33]);
        *(u32x4*)(WT + (size_t)(wt_row0 + n) * ldt + wt_k0 + 8 * c) = o; }
    asm volatile("s_waitcnt lgkmcnt(0)" ::: "memory");
}

__device__ __forceinline__ void p0_prologue(const Args& a, LAS unsigned char* lds, int tid, int lane, int wave) {
    unsigned char* ws = a.ws;
    const int G = gridDim.x;
    {
        LAS float* scw = (LAS float*)(lds + wave * 9216);
        LAS float* red = (LAS float*)(lds + 73728);
        float* mod = (float*)(ws + WS_MOD);
        for (int item = blockIdx.x; item < 192; item += G) {
            const int layer = item / 96, n0 = (item % 96) * 64;
            const float* W = a.in[5] + (size_t)layer * D * 6144;
            float acc[NBATCH];
#pragma unroll
            for (int b = 0; b < NBATCH; ++b) acc[b] = 0.f;
            for (int half = 0; half < 2; ++half) {
                const int kbase = wave * 128 + half * 64;
                for (int e = lane; e < NBATCH * 64; e += 64) { const int b = e >> 6, k = e & 63;
                    const float cv = (b < 2) ? a.in[2][b * D + kbase + k] : a.in[3][(b - 2) * D + kbase + k];
                    scw[k * 36 + b] = cv / (1.0f + __expf(-cv)); }
                asm volatile("s_waitcnt lgkmcnt(0)" ::: "memory");
                for (int k = 0; k < 64; ++k) {
                    const float w = W[(size_t)(kbase + k) * 6144 + n0 + lane];
                    const LAS f32x4* sp = (const LAS f32x4*)(scw + k * 36);
#pragma unroll
                    for (int q = 0; q < 8; ++q) { const f32x4 s4 = sp[q]; acc[4 * q] += s4[0] * w; acc[4 * q + 1] += s4[1] * w; acc[4 * q + 2] += s4[2] * w; acc[4 * q + 3] += s4[3] * w; }
                    { const f32x4 s4 = sp[8]; acc[32] += s4[0] * w; acc[33] += s4[1] * w; }
                }
                asm volatile("s_waitcnt lgkmcnt(0)" ::: "memory");
            }
#pragma unroll
            for (int b = 0; b < NBATCH; ++b) red[(wave * NBATCH + b) * 64 + lane] = acc[b];
            __syncthreads();
            for (int e = tid; e < NBATCH * 64; e += NTHR) { const int b = e >> 6, n = e & 63; float s = a.in[6][layer * 6144 + n0 + n];
#pragma unroll
                for (int w = 0; w < 8; ++w) s += red[(w * NBATCH + b) * 64 + n];
                mod[((size_t)layer * NBATCH + b) * 6144 + n0 + n] = s; }
            __syncthreads();
        }
    }
    __syncthreads();
    {
        LAS float* scr = (LAS float*)(lds + wave * 16384);
        const int gw = blockIdx.x * NWAVES + wave, NGW = G * NWAVES;
        constexpr int I_WIN = (D / 64) * (EVEN_IN / 32);
        constexpr int I_WO0 = (512 / 64) * (D / 32);
        constexpr int I_QKV = (D / 64) * (QKV / 32);
        constexpr int I_WO1 = (D / 64) * (D / 32);
        constexpr int I_GU = (D / 64) * (DFF / 32);
        constexpr int I_DN = (DFF / 64) * (D / 32);
        constexpr int NITEMS = I_WIN + I_WO0 + I_QKV + I_WO1 + 4 * I_GU + 2 * I_DN;
        for (int it = gw; it < NITEMS; it += NGW) {
            int r = it;
            if (r < I_WIN) { const int nb = EVEN_IN / 32; transpose_item(a.in[10], EVEN_IN, 64 * (r / nb), 32 * (r % nb), (bf16_t*)(ws + WS_WIN), D, 32 * (r % nb), 64 * (r / nb), scr, lane); continue; } r -= I_WIN;
            if (r < I_WO0) { const int nb = D / 32; transpose_item(a.in[11], D, 64 * (r / nb), 32 * (r % nb), (bf16_t*)(ws + WS_WOUT0), D, 32 * (r % nb), 64 * (r / nb), scr, lane); continue; } r -= I_WO0;
            if (r < I_QKV) { const int nb = QKV / 32; transpose_item(a.in[15], QKV, 64 * (r / nb), 32 * (r % nb), (bf16_t*)(ws + WS_WQKV), D, 32 * (r % nb), 64 * (r / nb), scr, lane); continue; } r -= I_QKV;
            if (r < I_WO1) { const int nb = D / 32; transpose_item(a.in[16], D, 64 * (r / nb), 32 * (r % nb), (bf16_t*)(ws + WS_WOUT1), D, 32 * (r % nb), 64 * (r / nb), scr, lane); continue; } r -= I_WO1;
            if (r < 4 * I_GU) { const int which = r / I_GU, layer = which >> 1, up = which & 1; r -= which * I_GU; const int nb = DFF / 32; const int n0 = 32 * (r % nb), k0 = 64 * (r / nb);
                const float* W = a.in[up ? 8 : 7] + (size_t)layer * D * DFF;
                const int row0 = (n0 >> 7) * 256 + up * 128 + (n0 & 127);
                transpose_item(W, DFF, k0, n0, (bf16_t*)(ws + WS_WGU) + (size_t)layer * NGU * D, D, row0, k0, scr, lane); continue; } r -= 4 * I_GU;
            { const int layer = r / I_DN; r -= layer * I_DN; const int nb = D / 32; const int n0 = 32 * (r % nb), k0 = 64 * (r / nb);
                transpose_item(a.in[9] + (size_t)layer * DFF * D, D, k0, n0, (bf16_t*)(ws + WS_WD) + (size_t)layer * D * DFF, DFF, n0, k0, scr, lane); }
        }
        const float* pw = a.in[12]; const float* psc = a.in[13]; const float* wo = a.in[11];
        bf16_t* WT = (bf16_t*)(ws + WS_WOUT0);
        for (int it = gw; it < 16 * 64; it += NGW) {
            const int nch = it & 15, cch = it >> 4, g = cch >> 4, c0 = (cch & 15) * 8, n = nch * 64 + lane;
            float acc[8];
#pragma unroll
            for (int j = 0; j < 8; ++j) acc[j] = 0.f;
            for (int d = 0; d < 128; ++d) {
                const float w = wo[(size_t)(512 + 128 * g + d) * D + n] * psc[128 * g + d];
#pragma unroll
                for (int j = 0; j < 8; ++j) acc[j] += pw[((size_t)g * 128 + c0 + j) * 128 + d] * w;
            }
            u32x4 o; o.x = pk2(acc[0], acc[1]); o.y = pk2(acc[2], acc[3]); o.z = pk2(acc[4], acc[5]); o.w = pk2(acc[6], acc[7]);
            *(u32x4*)(WT + (size_t)n * D + 512 + 128 * g + c0) = o;
        }
    }
}

template <bool HAS_Y, bool WRITE_X, bool WRITE_H>
__device__ __forceinline__ void norm_pass(const float* xa, const float* xb, const bf16_t* Y, const float* gate, const float* gny,
                                          float* xout, bf16_t* H, const float* sh, const float* sc, const float* gnh, int lane, int wave) {
    const int gw = blockIdx.x * NWAVES + wave, NGW = gridDim.x * NWAVES;
    for (int m = gw; m < T; m += NGW) {
        const int b = batch_of(m);
        const float* xrow = (m < TP) ? xa + (size_t)m * D : xb + (size_t)(m - TP) * D;
        f32x4 x[4];
#pragma unroll
        for (int j = 0; j < 4; ++j) x[j] = *(const f32x4*)(xrow + 4 * lane + 256 * j);
        if constexpr (HAS_Y) {
            f32x4 y[4]; float ss = 0.f;
#pragma unroll
            for (int j = 0; j < 4; ++j) { const u32x2 w = *(const u32x2*)(Y + (size_t)m * D + 4 * lane + 256 * j);
                y[j] = (f32x4){bf_lo(w.x), bf_hi(w.x), bf_lo(w.y), bf_hi(w.y)}; ss += (y[j][0] * y[j][0] + y[j][1] * y[j][1]) + (y[j][2] * y[j][2] + y[j][3] * y[j][3]); }
            const float rstd = 1.0f / sqrtf(wave_sum(ss) * (1.0f / D) + EPS);
#pragma unroll
            for (int j = 0; j < 4; ++j) { const f32x4 gt = *(const f32x4*)(gate + (size_t)b * 6144 + 4 * lane + 256 * j); const f32x4 gn = *(const f32x4*)(gny + 4 * lane + 256 * j);
                x[j] = x[j] + gt * (y[j] * rstd * gn); }
        }
        if constexpr (WRITE_X) {
#pragma unroll
            for (int j = 0; j < 4; ++j) *(f32x4*)(xout + (size_t)m * D + 4 * lane + 256 * j) = x[j];
        }
        if constexpr (WRITE_H) {
            float ss = 0.f;
#pragma unroll
            for (int j = 0; j < 4; ++j) ss += (x[j][0] * x[j][0] + x[j][1] * x[j][1]) + (x[j][2] * x[j][2] + x[j][3] * x[j][3]);
            const float rstd = 1.0f / sqrtf(wave_sum(ss) * (1.0f / D) + EPS);
#pragma unroll
            for (int j = 0; j < 4; ++j) { const int col = 4 * lane + 256 * j;
                const f32x4 gn = *(const f32x4*)(gnh + col), s1 = *(const f32x4*)(sc + (size_t)b * 6144 + col), s0 = *(const f32x4*)(sh + (size_t)b * 6144 + col);
                const f32x4 h = (x[j] * rstd * gn) * (1.0f + s1) + s0;
                u32x2 w; w.x = pk2(h[0], h[1]); w.y = pk2(h[2], h[3]); *(u32x2*)(H + (size_t)m * D + col) = w; }
        }
    }
}

template <class F>
__device__ __forceinline__ void attn_wave(const bf16_t* Z, int pitch, int qcol, int kcol, int vcol, int nblk, const F& f,
                                          LAS unsigned char* vt, int lane, bf16_t* O, int opitch, int ocol, float* lse_out, int lse_stride) {
    const int q = lane & 31, hi = lane >> 5;
    const int qtok = f.qtok(q);
    bf16x8 qf[4];
    { const bf16_t* qp = Z + (size_t)qtok * pitch + qcol + 8 * hi;
#pragma unroll
      for (int ks = 0; ks < 4; ++ks) qf[ks] = *(const bf16x8*)(qp + 16 * ks); }
    f32x16 o0, o1;
#pragma unroll
    for (int r = 0; r < 16; ++r) { o0[r] = 0.f; o1[r] = 0.f; }
    float m = NEGF, l = 0.f;
    const unsigned tr_addr = (unsigned)(size_t)vt + (unsigned)((4 * hi + ((lane & 15) >> 2)) * 192 + 32 * ((lane >> 4) & 1) + 8 * (lane & 3));
    for (int kb = 0; kb < nblk; ++kb) {
        bf16x8 kf[4];
        { const bf16_t* kp = Z + (size_t)f.ktok(kb, q) * pitch + kcol + 8 * hi;
#pragma unroll
          for (int ks = 0; ks < 4; ++ks) kf[ks] = *(const bf16x8*)(kp + 16 * ks); }
        u32x4 vv[4];
#pragma unroll
        for (int i = 0; i < 4; ++i) { const int row = (lane >> 3) + 8 * i; vv[i] = *(const u32x4*)(Z + (size_t)f.ktok(kb, row) * pitch + vcol + 8 * (lane & 7)); }
#pragma unroll
        for (int i = 0; i < 4; ++i) { const int row = (lane >> 3) + 8 * i; *(LAS u32x4*)(vt + row * 192 + 16 * (lane & 7)) = vv[i]; }
        f32x16 s;
#pragma unroll
        for (int r = 0; r < 16; ++r) s[r] = 0.f;
#pragma unroll
        for (int ks = 0; ks < 4; ++ks) s = __builtin_amdgcn_mfma_f32_32x32x16_bf16(kf[ks], qf[ks], s, 0, 0, 0);
        float mb = NEGF;
#pragma unroll
        for (int r = 0; r < 16; ++r) { const int key = (r & 3) + 8 * (r >> 2) + 4 * hi; s[r] = f.score(kb, key, q, s[r]); mb = fmaxf(mb, s[r]); }
        mb = fmaxf(mb, __shfl_xor(mb, 32));
        const float mn = fmaxf(m, mb);
        const float alpha = __expf(m - mn);
        float ps = 0.f;
#pragma unroll
        for (int r = 0; r < 16; ++r) { const float p = (s[r] > -1e29f) ? __expf(s[r] - mn) : 0.f; s[r] = p; ps += p; }
        ps += __shfl_xor(ps, 32);
        l = l * alpha + ps; m = mn;
#pragma unroll
        for (int r = 0; r < 16; ++r) { o0[r] *= alpha; o1[r] *= alpha; }
        bf16x8 pf[2];
#pragma unroll
        for (int j = 0; j < 2; ++j) { u32x4 w; w.x = pk2(s[8 * j], s[8 * j + 1]); w.y = pk2(s[8 * j + 2], s[8 * j + 3]); w.z = pk2(s[8 * j + 4], s[8 * j + 5]); w.w = pk2(s[8 * j + 6], s[8 * j + 7]);
            pf[j] = __builtin_bit_cast(bf16x8, w); }
        s16x4 a00, a01, a10, a11, b00, b01, b10, b11;
        asm volatile("s_waitcnt lgkmcnt(0)\n\t"
                     "ds_read_b64_tr_b16 %0, %8 offset:0\n\t"
                     "ds_read_b64_tr_b16 %1, %8 offset:1536\n\t"
                     "ds_read_b64_tr_b16 %2, %8 offset:3072\n\t"
                     "ds_read_b64_tr_b16 %3, %8 offset:4608\n\t"
                     "ds_read_b64_tr_b16 %4, %8 offset:64\n\t"
                     "ds_read_b64_tr_b16 %5, %8 offset:1600\n\t"
                     "ds_read_b64_tr_b16 %6, %8 offset:3136\n\t"
                     "ds_read_b64_tr_b16 %7, %8 offset:4672\n\t"
                     "s_waitcnt lgkmcnt(0)"
                     : "=&v"(a00), "=&v"(a01), "=&v"(a10), "=&v"(a11), "=&v"(b00), "=&v"(b01), "=&v"(b10), "=&v"(b11) : "v"(tr_addr) : "memory");
        const bf16x8 va0 = __builtin_shufflevector(a00, a01, 0, 1, 2, 3, 4, 5, 6, 7), va1 = __builtin_shufflevector(a10, a11, 0, 1, 2, 3, 4, 5, 6, 7);
        const bf16x8 vb0 = __builtin_shufflevector(b00, b01, 0, 1, 2, 3, 4, 5, 6, 7), vb1 = __builtin_shufflevector(b10, b11, 0, 1, 2, 3, 4, 5, 6, 7);
        o0 = __builtin_amdgcn_mfma_f32_32x32x16_bf16(va0, pf[0], o0, 0, 0, 0);
        o0 = __builtin_amdgcn_mfma_f32_32x32x16_bf16(va1, pf[1], o0, 0, 0, 0);
        o1 = __builtin_amdgcn_mfma_f32_32x32x16_bf16(vb0, pf[0], o1, 0, 0, 0);
        o1 = __builtin_amdgcn_mfma_f32_32x32x16_bf16(vb1, pf[1], o1, 0, 0, 0);
    }
    const float inv = 1.0f / l;
    bf16_t* op = O + (size_t)qtok * opitch + ocol + 4 * hi;
#pragma unroll
    for (int g4 = 0; g4 < 4; ++g4) {
        u32x2 w0; w0.x = pk2(o0[4 * g4] * inv, o0[4 * g4 + 1] * inv); w0.y = pk2(o0[4 * g4 + 2] * inv, o0[4 * g4 + 3] * inv);
        u32x2 w1; w1.x = pk2(o1[4 * g4] * inv, o1[4 * g4 + 1] * inv); w1.y = pk2(o1[4 * g4 + 2] * inv, o1[4 * g4 + 3] * inv);
        *(u32x2*)(op + 8 * g4) = w0; *(u32x2*)(op + 32 + 8 * g4) = w1;
    }
    if (lse_out != nullptr && hi == 0) lse_out[(size_t)qtok * lse_stride] = m + __logf(l);
}

struct DilF {
    int seq0, Ls, dsh, rho, s0; const LAS float* lut;
    __device__ __forceinline__ int qtok(int q) const { return seq0 + ((s0 + q) << dsh) + rho; }
    __device__ __forceinline__ int ktok(int kb, int k) const { int sk = s0 - 64 + 32 * kb + k; sk = sk < 0 ? 0 : (sk > Ls - 1 ? Ls - 1 : sk); return seq0 + (sk << dsh) + rho; }
    __device__ __forceinline__ float score(int kb, int key, int q, float s) const {
        const int rel = -64 + 32 * kb + key - q, sk = s0 + q + rel; const bool valid = (rel >= -64) && (rel <= 64) && (sk >= 0) && (sk < Ls);
        int idx = rel + 64; idx = idx < 0 ? 0 : (idx > 128 ? 128 : idx);
        return valid ? s * 0.125f + lut[idx] : NEGF; }
};
struct NaF {
    int seq0, r, rs, qh; const LAS float* rpb;
    __device__ __forceinline__ int qtok(int q) const { return seq0 + r * 64 + 32 * qh + q; }
    __device__ __forceinline__ int ktok(int kb, int k) const { return seq0 + (rs + (kb >> 1)) * 64 + 32 * (kb & 1) + k; }
    __device__ __forceinline__ float score(int kb, int key, int q, float s) const {
        const int kc = 32 * (kb & 1) + key, qc = 32 * qh + q; int cs = qc - 8; cs = cs < 0 ? 0 : (cs > 48 ? 48 : cs);
        const bool valid = (kc >= cs) && (kc < cs + 16); const int rowoff = rs + (kb >> 1) - r + 7; int co = kc - qc + 15; co = co < 0 ? 0 : (co > 30 ? 30 : co);
        return valid ? s * 0.125f + rpb[rowoff * 31 + co] : NEGF; }
};

__device__ __forceinline__ void seq_of(int tok0, int& seq0, int& L) { if (tok0 < TP) { seq0 = tok0 & ~(LP - 1); L = LP; } else { seq0 = TP + ((tok0 - TP) & ~(LSM - 1)); L = LSM; } }

__device__ __forceinline__ void dilated_phase(const Args& a, LAS unsigned char* lds, int tid, int lane, int wave) {
    LAS float* lut = (LAS float*)(lds + 49152);
    for (int i = tid; i < 3 * 8 * 129; i += NTHR) { const int br = i / 1032, rem = i % 1032, h = rem / 129, j = rem % 129; lut[i] = a.in[14][T5B[br][j] * 8 + h]; }
    __syncthreads();
    LAS unsigned char* vt = lds + wave * 6144;
    const bf16_t* Z = (const bf16_t*)(a.ws + WS_Z);
    const int gw = blockIdx.x * NWAVES + wave, NGW = gridDim.x * NWAVES;
    constexpr int NT = (T / 512) * 8 * 3 * 16;
    for (int task = gw; task < NT; task += NGW) {
        const int i = task & 15; int rest = task >> 4; const int br = rest % 3; rest /= 3; const int h = rest & 7, chunk = rest >> 3;
        int seq0, L; seq_of(chunk * 512, seq0, L);
        const int off = chunk * 512 - seq0, dsh = 2 * br;
        DilF f; f.seq0 = seq0; f.Ls = L >> dsh; f.dsh = dsh; f.rho = i >> (4 - dsh); f.s0 = (off >> dsh) + 32 * (i & ((16 >> dsh) - 1)); f.lut = lut + (br * 8 + h) * 129;
        bf16_t* O = (bf16_t*)(a.ws + (br < 2 ? WS_OB01 + (size_t)br * T * 512 * 2 : WS_OB2));
        float* lse = (float*)(a.ws + WS_LSE) + (size_t)br * T * 8 + h;
        attn_wave(Z, EVEN_IN, h * 64, 512 + h * 64, 1024 + h * 64, 5, f, vt, lane, O, 512, h * 64, lse, 8);
    }
}

__device__ __forceinline__ void combine_pool_phase(const Args& a, int lane, int wave) {
    const bf16_t* Z = (const bf16_t*)(a.ws + WS_Z);
    const bf16_t* OB0 = (const bf16_t*)(a.ws + WS_OB01); const bf16_t* OB1 = OB0 + (size_t)T * 512; const bf16_t* OB2 = (const bf16_t*)(a.ws + WS_OB2);
    const float* LSE = (const float*)(a.ws + WS_LSE);
    bf16_t* MX = (bf16_t*)(a.ws + WS_MX);
    const int gw = blockIdx.x * NWAVES + wave, NGW = gridDim.x * NWAVES;
    for (int t = gw; t < T; t += NGW) {
        const int h = lane >> 3;
        const float l0 = LSE[(size_t)t * 8 + h], l1 = LSE[((size_t)T + t) * 8 + h], l2 = LSE[((size_t)2 * T + t) * 8 + h];
        const float mx = fmaxf(l0, fmaxf(l1, l2));
        float w0 = __expf(l0 - mx), w1 = __expf(l1 - mx), w2 = __expf(l2 - mx);
        const float inv = 1.0f / (w0 + w1 + w2); w0 *= inv; w1 *= inv; w2 *= inv;
        const u32x4 a0 = *(const u32x4*)(OB0 + (size_t)t * 512 + 8 * lane), a1 = *(const u32x4*)(OB1 + (size_t)t * 512 + 8 * lane), a2 = *(const u32x4*)(OB2 + (size_t)t * 512 + 8 * lane);
        u32x4 o;
#pragma unroll
        for (int j = 0; j < 4; ++j) { const float lo = w0 * bf_lo(a0[j]) + w1 * bf_lo(a1[j]) + w2 * bf_lo(a2[j]); const float hi = w0 * bf_hi(a0[j]) + w1 * bf_hi(a1[j]) + w2 * bf_hi(a2[j]); o[j] = pk2(lo, hi); }
        *(u32x4*)(MX + (size_t)t * D + 8 * lane) = o;
        int seq0, L; seq_of(t, seq0, L);
        const int tl = t - seq0, half = 1 << (lane >> 4);
        const int lo_t = (tl - half) < 0 ? 0 : (tl - half), hi_t = (tl + half) > L ? L : (tl + half);
        float sum[8];
#pragma unroll
        for (int j = 0; j < 8; ++j) sum[j] = 0.f;
        for (int tt = lo_t; tt < hi_t; ++tt) { const u32x4 u = *(const u32x4*)(Z + (size_t)(seq0 + tt) * EVEN_IN + 1536 + 8 * lane);
#pragma unroll
            for (int j = 0; j < 4; ++j) { sum[2 * j] += bf_lo(u[j]); sum[2 * j + 1] += bf_hi(u[j]); } }
        const float rc = 1.0f / (float)(hi_t - lo_t);
        const u32x4 uc = *(const u32x4*)(Z + (size_t)t * EVEN_IN + 1536 + 8 * lane);
        u32x4 p;
#pragma unroll
        for (int j = 0; j < 4; ++j) p[j] = pk2(sum[2 * j] * rc - bf_lo(uc[j]), sum[2 * j + 1] * rc - bf_hi(uc[j]));
        *(u32x4*)(MX + (size_t)t * D + 512 + 8 * lane) = p;
    }
}

__device__ __forceinline__ void na_phase(const Args& a, LAS unsigned char* lds, int tid, int lane, int wave) {
    LAS float* rpb = (LAS float*)(lds + 49152);
    for (int i = tid; i < 16 * 15 * 31; i += NTHR) rpb[i] = a.in[17][i];
    __syncthreads();
    LAS unsigned char* vt = lds + wave * 6144;
    const bf16_t* Z = (const bf16_t*)(a.ws + WS_Z);
    bf16_t* MX = (bf16_t*)(a.ws + WS_MX);
    const int gw = blockIdx.x * NWAVES + wave, NGW = gridDim.x * NWAVES;
    constexpr int NT = (T / 32) * 16;
    for (int task = gw; task < NT; task += NGW) {
        const int h = task & 15, tok0 = (task >> 4) * 32;
        int seq0, L; seq_of(tok0, seq0, L);
        const int off = tok0 - seq0, rows = L >> 6, r = off >> 6;
        int rs = r - 4; rs = rs < 0 ? 0 : (rs > rows - 8 ? rows - 8 : rs);
        NaF f; f.seq0 = seq0; f.r = r; f.rs = rs; f.qh = (off >> 5) & 1; f.rpb = rpb + h * 465;
        attn_wave(Z, QKV, h * 64, 1024 + h * 64, 2048 + h * 64, 16, f, vt, lane, MX, D, h * 64, nullptr, 0);
    }
}

constexpr int NPHASE = 17;
__global__ void __launch_bounds__(NTHR, 2) mega_fwd(Args a) {
    extern __shared__ __attribute__((aligned(16))) unsigned char lds_raw[];
    LAS unsigned char* lds = (LAS unsigned char*)lds_raw;
    const int tid = threadIdx.x, lane = tid & 63, wave = __builtin_amdgcn_readfirstlane(tid >> 6);
    const int G = gridDim.x;
    unsigned char* ws = a.ws;
    float* mod = (float*)(ws + WS_MOD);
    const float* ng = a.in[4];
    bf16_t* H = (bf16_t*)(ws + WS_H); bf16_t* Zb = (bf16_t*)(ws + WS_Z); bf16_t* MX = (bf16_t*)(ws + WS_MX);
    float* out = a.out;
    const int lo = a.ph_lo, hi = a.ph_hi;
#define IN(k) (lo <= (k) && (k) < hi)
#define SEAM(k) do { if (IN(k) && IN((k) + 1)) { cg::this_grid().sync(); } } while (0)
#define MODV(layer, sel) (mod + (size_t)(layer) * NBATCH * 6144 + (sel) * 1024)
#define NGV(layer, sel) (ng + ((layer) * 4 + (sel)) * 1024)
#define GEMM(Ap, Btp, N_, K_, EPI) do { pg8::Gemm g{Ap, Btp, T, N_, K_}; pg8::StaticOrder S; S.init(T, N_, G, (int)blockIdx.x); \
        pg8::gemm_phase<decltype(EPI), pg8::StaticOrder, true, true>(lds, g, S, EPI); } while (0)

    if (IN(0)) { p0_prologue(a, lds, tid, lane, wave); } SEAM(0);
    if (IN(1)) { norm_pass<false, false, true>(a.in[0], a.in[1], nullptr, nullptr, nullptr, nullptr, H, MODV(0, 0), MODV(0, 1), NGV(0, 0), lane, wave); } SEAM(1);
    if (IN(2)) { pg8::EpiBf16 E{Zb, EVEN_IN}; GEMM(H, (const bf16_t*)(ws + WS_WIN), EVEN_IN, D, E); } SEAM(2);
    if (IN(3)) { dilated_phase(a, lds, tid, lane, wave); } SEAM(3);
    if (IN(4)) { combine_pool_phase(a, lane, wave); } SEAM(4);
    if (IN(5)) { pg8::EpiBf16 E{H, D}; GEMM(MX, (const bf16_t*)(ws + WS_WOUT0), D, D, E); } SEAM(5);
    if (IN(6)) { norm_pass<true, true, true>(a.in[0], a.in[1], H, MODV(0, 2), NGV(0, 1), out, H, MODV(0, 3), MODV(0, 4), NGV(0, 2), lane, wave); } SEAM(6);
    if (IN(7)) { pg8::EpiSwiglu E{Zb, DFF}; GEMM(H, (const bf16_t*)(ws + WS_WGU), NGU, D, E); } SEAM(7);
    if (IN(8)) { pg8::EpiBf16 E{H, D}; GEMM(Zb, (const bf16_t*)(ws + WS_WD), D, DFF, E); } SEAM(8);
    if (IN(9)) { norm_pass<true, true, true>(out, out + (size_t)TP * D, H, MODV(0, 5), NGV(0, 3), out, H, MODV(1, 0), MODV(1, 1), NGV(1, 0), lane, wave); } SEAM(9);
    if (IN(10)) { pg8::EpiBf16 E{Zb, QKV}; GEMM(H, (const bf16_t*)(ws + WS_WQKV), QKV, D, E); } SEAM(10);
    if (IN(11)) { na_phase(a, lds, tid, lane, wave); } SEAM(11);
    if (IN(12)) { pg8::EpiBf16 E{H, D}; GEMM(MX, (const bf16_t*)(ws + WS_WOUT1), D, D, E); } SEAM(12);
    if (IN(13)) { norm_pass<true, true, true>(out, out + (size_t)TP * D, H, MODV(1, 2), NGV(1, 1), out, H, MODV(1, 3), MODV(1, 4), NGV(1, 2), lane, wave); } SEAM(13);
    if (IN(14)) { pg8::EpiSwiglu E{Zb, DFF}; GEMM(H, (const bf16_t*)(ws + WS_WGU) + (size_t)NGU * D, NGU, D, E); } SEAM(14);
    if (IN(15)) { pg8::EpiBf16 E{H, D}; GEMM(Zb, (const bf16_t*)(ws + WS_WD) + (size_t)D * DFF, D, DFF, E); } SEAM(15);
    if (IN(16)) { norm_pass<true, true, false>(out, out + (size_t)TP * D, H, MODV(1, 5), NGV(1, 3), out, nullptr, nullptr, nullptr, nullptr, lane, wave); }
#undef IN
#undef SEAM
}

extern "C" void kernel_launch(void* const* d_in, const int* in_sizes, int n_in, void* d_out, int out_size, void* d_ws, size_t ws_size, hipStream_t stream) {
    static int grid = 0;
    if (grid == 0) {
        if (n_in != 18 || out_size != T * D || ws_size < WS_END) { fprintf(stderr, "kernel_launch: unexpected shapes: n_in %d out %d ws %zu (need %zu)\n", n_in, out_size, ws_size, (size_t)WS_END); grid = -1; return; }
        int dev = 0, cus = 0, per_cu = 0;
        if (hipGetDevice(&dev) != hipSuccess || hipDeviceGetAttribute(&cus, hipDeviceAttributeMultiprocessorCount, dev) != hipSuccess) { grid = -1; return; }
        if (hipFuncSetAttribute((const void*)mega_fwd, hipFuncAttributeMaxDynamicSharedMemorySize, LDS_BYTES) != hipSuccess) { fprintf(stderr, "kernel_launch: hipFuncSetAttribute failed\n"); grid = -1; return; }
        if (hipOccupancyMaxActiveBlocksPerMultiprocessor(&per_cu, (const void*)mega_fwd, NTHR, LDS_BYTES) != hipSuccess || per_cu < 1) { fprintf(stderr, "kernel_launch: occupancy query says %d\n", per_cu); per_cu = 1; }
        (void)hipGetLastError();
        grid = cus * per_cu;
    }
    if (grid < 0) return;
    Args a{};
    for (int i = 0; i < 18; ++i) a.in[i] = (const float*)d_in[i];
    a.out = (float*)d_out; a.ws = (unsigned char*)d_ws;
#if MK_COOP
    a.ph_lo = 0; a.ph_hi = NPHASE;
    void* args[] = {&a};
    hipError_t e = hipLaunchCooperativeKernel((const void*)mega_fwd, dim3(grid), dim3(NTHR), args, LDS_BYTES, stream);
    if (e != hipSuccess) fprintf(stderr, "cooperative launch failed: %s (grid %d)\n", hipGetErrorString(e), grid);
#else
    for (int p = 0; p < NPHASE; ++p) { a.ph_lo = p; a.ph_hi = p + 1; hipLaunchKernelGGL(mega_fwd, dim3(grid), dim3(NTHR), LDS_BYTES, stream, a); }
#endif
}
```

```cpp
#include <hip/hip_runtime.h>
#include <hip/hip_cooperative_groups.h>
#include <cstdio>
#include <cstdint>
namespace cg = cooperative_groups;

#ifndef MK_COOP
#define MK_COOP 1
#endif
#ifndef PROBE_REP
#define PROBE_REP 0
#endif

#define LAS __attribute__((address_space(3)))
typedef unsigned short bf16_t;
typedef short bf16x8 __attribute__((ext_vector_type(8)));
typedef short s16x4 __attribute__((ext_vector_type(4)));
typedef float f32x4 __attribute__((ext_vector_type(4)));
typedef float f32x16 __attribute__((ext_vector_type(16)));
typedef unsigned u32x4 __attribute__((ext_vector_type(4)));
typedef unsigned u32x2 __attribute__((ext_vector_type(2)));

namespace pg8 {
constexpr int BM = 256, BK = 64, HALF = 128, HTB = HALF * BK * 2, STAGE_BYTES = 8 * HTB, NXCD = 8, WGM = 8;
__host__ __device__ __forceinline__ int lds_byte(int r, int c) { const int st = (r >> 4) * 2 + (c >> 5), rr = r & 15, cc = c & 31, ob = rr * 64 + cc * 2; return st * 1024 + (ob ^ (((ob >> 9) & 1) << 5)); }
__host__ __device__ __forceinline__ void stage_rc(int b, int& R, int& C) { const int st = b / 1024, sb = b % 1024, swz = sb ^ (((sb >> 9) & 1) << 5); R = (st >> 1) * 16 + swz / 64; C = (st & 1) * 32 + (swz % 64) / 2; }
__host__ __device__ __forceinline__ int perm32(int rho) { const int n = rho >> 4, i = rho & 15; return 8 * (i >> 2) + 4 * n + (i & 3); }

struct Unit { int pm, pn; };
struct Gemm { const bf16_t* A; const bf16_t* Bt; int M, N, K; };

struct StaticOrder {
    int nM, nN, nwg, G, c;
    __host__ __device__ void init(int M, int N, int G_, int c_) { nM = M / BM; nN = N / BM; nwg = nM * nN; G = G_; c = c_; }
    __host__ __device__ bool next(int i, Unit& u) const {
        const long L = (long)i * G + c; if (L >= nwg) return false;
        int wgid = (int)L; { const int q = nwg / NXCD, r = nwg % NXCD, xcd = wgid % NXCD, off = wgid / NXCD; wgid = (xcd < r ? xcd * (q + 1) : r * (q + 1) + (xcd - r) * q) + off; }
        const int nig = WGM * nN, gid = wgid / nig, fm = gid * WGM, gsz = (nM - fm) < WGM ? (nM - fm) : WGM;
        u.pm = fm + ((wgid % nig) % gsz); u.pn = (wgid % nig) / gsz; return true;
    }
    __device__ __forceinline__ void a_ready(const Unit&) const {}
    __device__ __forceinline__ void done(const Unit&) const {}
};

__device__ __forceinline__ unsigned cvt_pk_bf16(float lo, float hi) { unsigned r; asm volatile("v_cvt_pk_bf16_f32 %0, %1, %2" : "=v"(r) : "v"(lo), "v"(hi)); return r; }

struct EpiBf16 {
    static constexpr bool PERM = true, AFTER_DRAIN = false;
    bf16_t* O; int ldc;
    __device__ __forceinline__ void operator()(const f32x4 (&acc)[2][2][4][2], const Unit& u, int wr, int wc, int fr, int fq) const {
        const int row0 = u.pm * BM + wr * 64 + fr; const int col0 = u.pn * BM + wc * 32 + 8 * fq;
#pragma unroll
        for (int ai = 0; ai < 2; ++ai)
#pragma unroll
            for (int m = 0; m < 4; ++m) { bf16_t* rowp = O + (size_t)(row0 + ai * HALF + m * 16) * ldc + col0;
#pragma unroll
                for (int bj = 0; bj < 2; ++bj) { const f32x4 v0 = acc[ai][bj][m][0], v1 = acc[ai][bj][m][1];
                    u32x4 w; w.x = cvt_pk_bf16(v0[0], v0[1]); w.y = cvt_pk_bf16(v0[2], v0[3]); w.z = cvt_pk_bf16(v1[0], v1[1]); w.w = cvt_pk_bf16(v1[2], v1[3]);
                    *(u32x4*)(rowp + bj * HALF) = w; } }
    }
};
struct EpiSwiglu {
    static constexpr bool PERM = true, AFTER_DRAIN = false;
    bf16_t* O; int ldc;
    __device__ __forceinline__ void operator()(const f32x4 (&acc)[2][2][4][2], const Unit& u, int wr, int wc, int fr, int fq) const {
        const int row0 = u.pm * BM + wr * 64 + fr; const int col0 = u.pn * HALF + wc * 32 + 8 * fq;
#pragma unroll
        for (int ai = 0; ai < 2; ++ai)
#pragma unroll
            for (int m = 0; m < 4; ++m) { bf16_t* rowp = O + (size_t)(row0 + ai * HALF + m * 16) * ldc + col0;
                float r[8];
#pragma unroll
                for (int n = 0; n < 2; ++n)
#pragma unroll
                    for (int j = 0; j < 4; ++j) { const float g = acc[ai][0][m][n][j], up = acc[ai][1][m][n][j]; r[n * 4 + j] = g * __builtin_amdgcn_rcpf(1.0f + __expf(-g)) * up; }
                u32x4 w; w.x = cvt_pk_bf16(r[0], r[1]); w.y = cvt_pk_bf16(r[2], r[3]); w.z = cvt_pk_bf16(r[4], r[5]); w.w = cvt_pk_bf16(r[6], r[7]);
                *(u32x4*)rowp = w; }
    }
};

template <class Epi, class Sched, bool ALIGN_EPI = false, bool SP2 = false>
__device__ __forceinline__ void gemm_phase(LAS unsigned char* lds, const Gemm g, const Sched& S, const Epi& E) {
    const int tid = threadIdx.x, wid = __builtin_amdgcn_readfirstlane(tid >> 6), lane = tid & 63, wr = wid >> 2, wc = wid & 3, fr = lane & 15, fq = lane >> 4;
    const int K = g.K, nt = K / BK;
    unsigned voffA[2], voffB[2];
#pragma unroll
    for (int i = 0; i < 2; ++i) { int R, C; stage_rc(tid * 16 + i * 8192, R, C); const int Rb = Epi::PERM ? ((R & ~31) + perm32(R & 31)) : R;
        voffA[i] = (unsigned)(R * K + C) * 2u; voffB[i] = (unsigned)(Rb * K + C) * 2u; }
    const size_t kstep = (size_t)(BK * 2);
    const size_t hstep = (size_t)HALF * K * 2;
    const size_t tstep = 2 * hstep;
    const unsigned ldsw = (unsigned)wid * 1024u;
    const int aoff = lds_byte(wr * 64 + fr, fq * 8), boff = lds_byte(wc * 32 + fr, fq * 8);
#define PG8_SA(b, h) (((b) * 2 + (h)) * HTB)
#define PG8_SB(b, h) ((4 + (b) * 2 + (h)) * HTB)
#define PG8_STAGE(bufoff, gbase, voff) do { _Pragma("unroll") for (int _i = 0; _i < 2; ++_i) \
        __builtin_amdgcn_global_load_lds((const unsigned*)((const char*)(gbase) + (voff)[_i]), (LAS unsigned*)(lds + (bufoff) + ldsw + _i * 8192), 16, 0, 0); } while (0)
#define PG8_LDA(dst, b, h) do { _Pragma("unroll") for (int m = 0; m < 4; ++m) _Pragma("unroll") for (int k = 0; k < 2; ++k) dst[m][k] = *(const LAS bf16x8*)(lds + PG8_SA(b, h) + aoff + m * 2048 + k * 1024); } while (0)
#define PG8_LDB(dst, b, h) do { _Pragma("unroll") for (int n = 0; n < 2; ++n) _Pragma("unroll") for (int k = 0; k < 2; ++k) dst[n][k] = *(const LAS bf16x8*)(lds + PG8_SB(b, h) + boff + n * 2048 + k * 1024); } while (0)
#define PG8_MMA(ai, bj, At, Bt) do { __builtin_amdgcn_s_setprio(1); _Pragma("unroll") for (int m = 0; m < 4; ++m) _Pragma("unroll") for (int n = 0; n < 2; ++n) _Pragma("unroll") for (int k = 0; k < 2; ++k) \
        acc[ai][bj][m][n] = __builtin_amdgcn_mfma_f32_16x16x32_bf16(Bt[n][k], At[m][k], acc[ai][bj][m][n], 0, 0, 0); __builtin_amdgcn_s_setprio(0); } while (0)
#define PG8_WAIT_V(n) asm volatile("s_waitcnt vmcnt(" #n ")" ::: "memory")
#define PG8_WAIT_L(n) asm volatile("s_waitcnt lgkmcnt(" #n ")" ::: "memory")
#define PG8_BAR __builtin_amdgcn_s_barrier()
#define PG8_SCHED __builtin_amdgcn_sched_barrier(0)
    Unit cur, nxt; int ui = 0;
    if (!S.next(0, cur)) return;
    f32x4 acc[2][2][4][2];
#pragma unroll
    for (int a = 0; a < 2; ++a)
#pragma unroll
        for (int b = 0; b < 2; ++b)
#pragma unroll
            for (int m = 0; m < 4; ++m)
#pragma unroll
                for (int n = 0; n < 2; ++n) acc[a][b][m][n] = (f32x4){0.f, 0.f, 0.f, 0.f};
    bf16x8 At[4][2], B0[2][2], B1[2][2];
    const char* cA = (const char*)g.A + (size_t)cur.pm * tstep; const char* cB = (const char*)g.Bt + (size_t)cur.pn * tstep;
    S.a_ready(cur);
    if constexpr (SP2) {
        PG8_STAGE(PG8_SB(0, 0), cB, voffB); PG8_STAGE(PG8_SB(0, 1), cB + hstep, voffB); PG8_STAGE(PG8_SA(0, 0), cA, voffA); PG8_STAGE(PG8_SA(0, 1), cA + hstep, voffA);
        if (wr == 1) PG8_BAR;
        PG8_WAIT_V(2); PG8_BAR;
        PG8_STAGE(PG8_SB(1, 0), cB + kstep, voffB); PG8_STAGE(PG8_SA(1, 0), cA + kstep, voffA); PG8_STAGE(PG8_SB(1, 1), cB + hstep + kstep, voffB);
        PG8_WAIT_V(6); PG8_BAR;
    } else {
        PG8_STAGE(PG8_SB(0, 0), cB, voffB); PG8_STAGE(PG8_SA(0, 0), cA, voffA); PG8_STAGE(PG8_SB(0, 1), cB + hstep, voffB); PG8_STAGE(PG8_SA(0, 1), cA + hstep, voffA);
        if (wr == 1) PG8_BAR;
        PG8_WAIT_V(4); PG8_BAR;
        PG8_STAGE(PG8_SB(1, 0), cB + kstep, voffB); PG8_STAGE(PG8_SA(1, 0), cA + kstep, voffA); PG8_STAGE(PG8_SB(1, 1), cB + hstep + kstep, voffB);
        PG8_WAIT_V(6); PG8_BAR;
    }
    for (;;) {
        const bool has_next = S.next(ui + 1, nxt);
        const char* nA = has_next ? (const char*)g.A + (size_t)nxt.pm * tstep : cA; const char* nB = has_next ? (const char*)g.Bt + (size_t)nxt.pn * tstep : cB;
        for (int t = 0; t < nt; t += 2) {
            const bool last = (t == nt - 2);
            const char* a1 = cA + (size_t)(t + 1) * kstep;
            const char* a2 = last ? nA : cA + (size_t)(t + 2) * kstep; const char* b2 = last ? nB : cB + (size_t)(t + 2) * kstep;
            const char* a3 = a2 + kstep; const char* b3 = b2 + kstep;
            if (last && has_next) S.a_ready(nxt);
            if constexpr (SP2) {
            PG8_LDB(B0, 0, 0); PG8_LDB(B1, 0, 1); PG8_SCHED; PG8_LDA(At, 0, 0); PG8_STAGE(PG8_SA(1, 1), a1 + hstep, voffA);
            PG8_WAIT_V(8); PG8_WAIT_L(0); PG8_BAR; PG8_MMA(0, 0, At, B0); PG8_MMA(0, 1, At, B1); PG8_BAR; PG8_SCHED;
            PG8_LDA(At, 0, 1); PG8_STAGE(PG8_SB(0, 0), b2, voffB); PG8_STAGE(PG8_SB(0, 1), b2 + hstep, voffB); PG8_STAGE(PG8_SA(0, 0), a2, voffA);
            PG8_WAIT_V(8); PG8_WAIT_L(0); PG8_BAR; PG8_MMA(1, 0, At, B0); PG8_MMA(1, 1, At, B1); PG8_BAR; PG8_SCHED;
            PG8_LDB(B0, 1, 0); PG8_LDB(B1, 1, 1); PG8_SCHED; PG8_LDA(At, 1, 0); PG8_STAGE(PG8_SA(0, 1), a2 + hstep, voffA);
            PG8_WAIT_V(8); PG8_WAIT_L(0); PG8_BAR; PG8_MMA(0, 0, At, B0); PG8_MMA(0, 1, At, B1); PG8_BAR; PG8_SCHED;
            PG8_LDA(At, 1, 1); PG8_STAGE(PG8_SB(1, 0), b3, voffB); PG8_STAGE(PG8_SB(1, 1), b3 + hstep, voffB); PG8_STAGE(PG8_SA(1, 0), a3, voffA);
            PG8_WAIT_V(8); PG8_WAIT_L(0); PG8_BAR; PG8_MMA(1, 0, At, B0); PG8_MMA(1, 1, At, B1); PG8_BAR; PG8_SCHED;
            } else {
            PG8_LDB(B0, 0, 0); PG8_SCHED; PG8_LDA(At, 0, 0); PG8_STAGE(PG8_SA(1, 1), a1 + hstep, voffA);
            PG8_WAIT_L(8); PG8_BAR; PG8_WAIT_L(0); PG8_MMA(0, 0, At, B0); PG8_BAR; PG8_SCHED;
            PG8_LDB(B1, 0, 1); PG8_STAGE(PG8_SB(0, 0), b2, voffB);
            PG8_BAR; PG8_WAIT_L(0); PG8_MMA(0, 1, At, B1); PG8_BAR;
            PG8_LDA(At, 0, 1); PG8_STAGE(PG8_SA(0, 0), a2, voffA);
            PG8_BAR; PG8_WAIT_L(0); PG8_MMA(1, 0, At, B0); PG8_BAR; PG8_SCHED;
            PG8_STAGE(PG8_SB(0, 1), b2 + hstep, voffB);
            PG8_WAIT_V(6); PG8_BAR; PG8_MMA(1, 1, At, B1); PG8_BAR;
            PG8_LDB(B0, 1, 0); PG8_SCHED; PG8_LDA(At, 1, 0); PG8_STAGE(PG8_SA(0, 1), a2 + hstep, voffA);
            PG8_WAIT_L(8); PG8_BAR; PG8_WAIT_L(0); PG8_MMA(0, 0, At, B0); PG8_BAR; PG8_SCHED;
            PG8_LDB(B1, 1, 1); PG8_STAGE(PG8_SB(1, 0), b3, voffB);
            PG8_BAR; PG8_WAIT_L(0); PG8_MMA(0, 1, At, B1); PG8_BAR;
            PG8_LDA(At, 1, 1); PG8_STAGE(PG8_SA(1, 0), a3, voffA);
            PG8_BAR; PG8_WAIT_L(0); PG8_MMA(1, 0, At, B0); PG8_BAR; PG8_SCHED;
            PG8_STAGE(PG8_SB(1, 1), b3 + hstep, voffB);
            PG8_WAIT_V(6); PG8_BAR; PG8_MMA(1, 1, At, B1); PG8_BAR;
            }
        }
        if constexpr (ALIGN_EPI) { if (wr == 0) PG8_BAR; }
        if constexpr (!Epi::AFTER_DRAIN) { E(acc, cur, wr, wc, fr, fq); S.done(cur); }
        if (!has_next) break;
#pragma unroll
        for (int a = 0; a < 2; ++a)
#pragma unroll
            for (int b = 0; b < 2; ++b)
#pragma unroll
                for (int m = 0; m < 4; ++m)
#pragma unroll
                    for (int n = 0; n < 2; ++n) acc[a][b][m][n] = (f32x4){0.f, 0.f, 0.f, 0.f};
        cur = nxt; cA = nA; cB = nB; ++ui;
        if constexpr (ALIGN_EPI) { if (wr == 1) PG8_BAR; }
    }
    PG8_WAIT_V(0);
    if constexpr (!ALIGN_EPI) { if (wr == 0) PG8_BAR; }
    PG8_BAR;
#undef PG8_SA
#undef PG8_SB
#undef PG8_STAGE
#undef PG8_LDA
#undef PG8_LDB
#undef PG8_MMA
#undef PG8_WAIT_V
#undef PG8_WAIT_L
#undef PG8_BAR
#undef PG8_SCHED
}
}

constexpr int NWAVES = 8, NTHR = 512;
constexpr int D = 1024, DFF = 2816, NGU = 2 * DFF;
constexpr int TP = 32768, TSM = 65536, T = TP + TSM, LP = 16384, LSM = 2048, NBATCH = 34;
constexpr int EVEN_IN = 2048, QKV = 3072;
constexpr float EPS = 1e-6f;
constexpr float NEGF = -1e30f;

constexpr size_t MiB = 1u << 20;
constexpr size_t WS_MOD = 0;
constexpr size_t WS_WIN = 2 * MiB;
constexpr size_t WS_WOUT0 = 6 * MiB;
constexpr size_t WS_WQKV = 8 * MiB;
constexpr size_t WS_WOUT1 = 14 * MiB;
constexpr size_t WS_WGU = 16 * MiB;
constexpr size_t WS_WD = 38 * MiB;
constexpr size_t WS_H = 50 * MiB;
constexpr size_t WS_Z = 242 * MiB;
constexpr size_t WS_MX = 818 * MiB;
constexpr size_t WS_OB01 = 626 * MiB;
constexpr size_t WS_OB2 = 50 * MiB;
constexpr size_t WS_LSE = 146 * MiB;
constexpr size_t WS_END = 1010 * MiB;
constexpr int LDS_BYTES = 147456;

__device__ const unsigned char T5B[3][129] = {
{11,11,11,11,11,11,11,11,11,11,11,11,11,11,11,10,10,10,10,10,10,10,10,10,10,10,10,10,10,10,10,10,10,10,10,10,10,10,9,9,9,9,9,9,9,9,9,9,9,9,8,8,8,8,8,8,8,7,6,5,4,3,2,1,0,17,18,19,20,21,22,23,24,24,24,24,24,24,24,25,25,25,25,25,25,25,25,25,25,25,25,26,26,26,26,26,26,26,26,26,26,26,26,26,26,26,26,26,26,26,26,26,26,26,27,27,27,27,27,27,27,27,27,27,27,27,27,27,27},
{13,13,13,13,13,13,13,13,13,13,13,13,13,13,13,13,13,13,13,13,13,13,13,12,12,12,12,12,12,12,12,12,12,12,12,12,12,12,12,12,12,12,11,11,11,11,11,11,11,11,11,11,10,10,10,10,10,10,9,9,9,8,8,4,0,20,24,24,25,25,25,26,26,26,26,26,26,27,27,27,27,27,27,27,27,27,27,28,28,28,28,28,28,28,28,28,28,28,28,28,28,28,28,28,28,28,29,29,29,29,29,29,29,29,29,29,29,29,29,29,29,29,29,29,29,29,29,29,29},
{15,15,15,15,15,15,15,15,15,15,15,15,15,15,15,15,15,15,15,15,15,15,15,15,15,15,15,15,15,15,14,14,14,14,14,14,14,14,14,14,14,14,14,14,14,13,13,13,13,13,13,13,13,13,12,12,12,12,12,11,11,10,10,9,0,25,26,26,27,27,28,28,28,28,28,29,29,29,29,29,29,29,29,29,30,30,30,30,30,30,30,30,30,30,30,30,30,30,30,31,31,31,31,31,31,31,31,31,31,31,31,31,31,31,31,31,31,31,31,31,31,31,31,31,31,31,31,31,31}};

struct Args {
    const float* in[18];
    float* out;
    unsigned char* ws;
    int ph_lo, ph_hi;
};

__device__ __forceinline__ unsigned f2bf(float f) { unsigned u = __builtin_bit_cast(unsigned, f); return (u + 0x7fffu + ((u >> 16) & 1u)) >> 16; }
__device__ __forceinline__ unsigned pk2(float lo, float hi) { return pg8::cvt_pk_bf16(lo, hi); }
__device__ __forceinline__ float bf_lo(unsigned u) { return __builtin_bit_cast(float, u << 16); }
__device__ __forceinline__ float bf_hi(unsigned u) { return __builtin_bit_cast(float, u & 0xffff0000u); }
__device__ __forceinline__ float wave_sum(float v) {
#pragma unroll
    for (int o = 1; o < 64; o <<= 1) v += __shfl_xor(v, o);
    return v;
}
__device__ __forceinline__ int batch_of(int m) { return m < TP ? (m >> 14) : 2 + ((m - TP) >> 11); }

__device__ __forceinline__ void transpose_item(const float* W, int ldw, int k0, int n0, bf16_t* WT, int ldt, int wt_row0, int wt_k0, LAS float* scr, int lane) {
#pragma unroll 8
    for (int i = 0; i < 32; ++i) { const int kk = 2 * i + (lane >> 5); scr[kk * 33 + (lane & 31)] = W[(size_t)(k0 + kk) * ldw + n0 + (lane & 31)]; }
    asm volatile("s_waitcnt lgkmcnt(0)" ::: "memory");
    const int c = lane & 7;
#pragma unroll
    for (int j = 0; j < 4; ++j) { const int n = (lane >> 3) + 8 * j; const LAS float* s = scr + (8 * c) * 33 + n;
        u32x4 o; o.x = pk2(s[0 * 33], s[1 * 33]); o.y = pk2(s[2 * 33], s[3 * 33]); o.z = pk2(s[4 * 33], s[5 * 33]); o.w = pk2(s[6 * 33], s[7 * 33]);
        *(u32x4*)(WT + (size_t)(wt_row0 + n) * ldt + wt_k0 + 8 * c) = o; }
    asm volatile("s_waitcnt lgkmcnt(0)" ::: "memory");
}

__device__ __forceinline__ void p0_prologue(const Args& a, LAS unsigned char* lds, int tid, int lane, int wave) {
    unsigned char* ws = a.ws;
    const int G = gridDim.x;
    {
        LAS float* scw = (LAS float*)(lds + wave * 9216);
        LAS float* red = (LAS float*)(lds + 73728);
        float* mod = (float*)(ws + WS_MOD);
        for (int item = blockIdx.x; item < 192; item += G) {
            const int layer = item / 96, n0 = (item % 96) * 64;
            const float* W = a.in[5] + (size_t)layer * D * 6144;
            float acc[NBATCH];
#pragma unroll
            for (int b = 0; b < NBATCH; ++b) acc[b] = 0.f;
            for (int half = 0; half < 2; ++half) {
                const int kbase = wave * 128 + half * 64;
                for (int e = lane; e < NBATCH * 64; e += 64) { const int b = e >> 6, k = e & 63;
                    const float cv = (b < 2) ? a.in[2][b * D + kbase + k] : a.in[3][(b - 2) * D + kbase + k];
                    scw[k * 36 + b] = cv / (1.0f + __expf(-cv)); }
                asm volatile("s_waitcnt lgkmcnt(0)" ::: "memory");
                for (int k = 0; k < 64; ++k) {
                    const float w = W[(size_t)(kbase + k) * 6144 + n0 + lane];
                    const LAS f32x4* sp = (const LAS f32x4*)(scw + k * 36);
#pragma unroll
                    for (int q = 0; q < 8; ++q) { const f32x4 s4 = sp[q]; acc[4 * q] += s4[0] * w; acc[4 * q + 1] += s4[1] * w; acc[4 * q + 2] += s4[2] * w; acc[4 * q + 3] += s4[3] * w; }
                    { const f32x4 s4 = sp[8]; acc[32] += s4[0] * w; acc[33] += s4[1] * w; }
                }
                asm volatile("s_waitcnt lgkmcnt(0)" ::: "memory");
            }
#pragma unroll
            for (int b = 0; b < NBATCH; ++b) red[(wave * NBATCH + b) * 64 + lane] = acc[b];
            __syncthreads();
            for (int e = tid; e < NBATCH * 64; e += NTHR) { const int b = e >> 6, n = e & 63; float s = a.in[6][layer * 6144 + n0 + n];
#pragma unroll
                for (int w = 0; w < 8; ++w) s += red[(w * NBATCH + b) * 64 + n];
                mod[((size_t)layer * NBATCH + b) * 6144 + n0 + n] = s; }
            __syncthreads();
        }
    }
    __syncthreads();
    {
        LAS float* scr = (LAS float*)(lds + wave * 16384);
        const int gw = blockIdx.x * NWAVES + wave, NGW = G * NWAVES;
        constexpr int I_WIN = (D / 64) * (EVEN_IN / 32);
        constexpr int I_WO0 = (512 / 64) * (D / 32);
        constexpr int I_QKV = (D / 64) * (QKV / 32);
        constexpr int I_WO1 = (D / 64) * (D / 32);
        constexpr int I_GU = (D / 64) * (DFF / 32);
        constexpr int I_DN = (DFF / 64) * (D / 32);
        constexpr int NITEMS = I_WIN + I_WO0 + I_QKV + I_WO1 + 4 * I_GU + 2 * I_DN;
        for (int it = gw; it < NITEMS; it += NGW) {
            int r = it;
            if (r < I_WIN) { const int nb = EVEN_IN / 32; transpose_item(a.in[10], EVEN_IN, 64 * (r / nb), 32 * (r % nb), (bf16_t*)(ws + WS_WIN), D, 32 * (r % nb), 64 * (r / nb), scr, lane); continue; } r -= I_WIN;
            if (r < I_WO0) { const int nb = D / 32; transpose_item(a.in[11], D, 64 * (r / nb), 32 * (r % nb), (bf16_t*)(ws + WS_WOUT0), D, 32 * (r % nb), 64 * (r / nb), scr, lane); continue; } r -= I_WO0;
            if (r < I_QKV) { const int nb = QKV / 32; transpose_item(a.in[15], QKV, 64 * (r / nb), 32 * (r % nb), (bf16_t*)(ws + WS_WQKV), D, 32 * (r % nb), 64 * (r / nb), scr, lane); continue; } r -= I_QKV;
            if (r < I_WO1) { const int nb = D / 32; transpose_item(a.in[16], D, 64 * (r / nb), 32 * (r % nb), (bf16_t*)(ws + WS_WOUT1), D, 32 * (r % nb), 64 * (r / nb), scr, lane); continue; } r -= I_WO1;
            if (r < 4 * I_GU) { const int which = r / I_GU, layer = which >> 1, up = which & 1; r -= which * I_GU; const int nb = DFF / 32; const int n0 = 32 * (r % nb), k0 = 64 * (r / nb);
                const float* W = a.in[up ? 8 : 7] + (size_t)layer * D * DFF;
                const int row0 = (n0 >> 7) * 256 + up * 128 + (n0 & 127);
                transpose_item(W, DFF, k0, n0, (bf16_t*)(ws + WS_WGU) + (size_t)layer * NGU * D, D, row0, k0, scr, lane); continue; } r -= 4 * I_GU;
            { const int layer = r / I_DN; r -= layer * I_DN; const int nb = D / 32; const int n0 = 32 * (r % nb), k0 = 64 * (r / nb);
                transpose_item(a.in[9] + (size_t)layer * DFF * D, D, k0, n0, (bf16_t*)(ws + WS_WD) + (size_t)layer * D * DFF, DFF, n0, k0, scr, lane); }
        }
        const float* pw = a.in[12]; const float* psc = a.in[13]; const float* wo = a.in[11];
        bf16_t* WT = (bf16_t*)(ws + WS_WOUT0);
        for (int it = gw; it < 16 * 64; it += NGW) {
            const int nch = it & 15, cch = it >> 4, g = cch >> 4, c0 = (cch & 15) * 8, n = nch * 64 + lane;
            float acc[8];
#pragma unroll
            for (int j = 0; j < 8; ++j) acc[j] = 0.f;
            for (int d = 0; d < 128; ++d) {
                const float w = wo[(size_t)(512 + 128 * g + d) * D + n] * psc[128 * g + d];
#pragma unroll
                for (int j = 0; j < 8; ++j) acc[j] += pw[((size_t)g * 128 + c0 + j) * 128 + d] * w;
            }
            u32x4 o; o.x = pk2(acc[0], acc[1]); o.y = pk2(acc[2], acc[3]); o.z = pk2(acc[4], acc[5]); o.w = pk2(acc[6], acc[7]);
            *(u32x4*)(WT + (size_t)n * D + 512 + 128 * g + c0) = o;
        }
    }
}

template <bool HAS_Y, bool WRITE_X, bool WRITE_H>
__device__ __forceinline__ void norm_pass(const float* xa, const float* xb, const bf16_t* Y, const float* gate, const float* gny,
                                          float* xout, bf16_t* H, const float* sh, const float* sc, const float* gnh, int lane, int wave) {
    const int gw = blockIdx.x * NWAVES + wave, NGW = gridDim.x * NWAVES;
    for (int m = gw; m < T; m += NGW) {
        const int b = batch_of(m);
        const float* xrow = (m < TP) ? xa + (size_t)m * D : xb + (size_t)(m - TP) * D;
        f32x4 x[4];
#pragma unroll
        for (int j = 0; j < 4; ++j) x[j] = *(const f32x4*)(xrow + 4 * lane + 256 * j);
        if constexpr (HAS_Y) {
            f32x4 y[4]; float ss = 0.f;
#pragma unroll
            for (int j = 0; j < 4; ++j) { const u32x2 w = *(const u32x2*)(Y + (size_t)m * D + 4 * lane + 256 * j);
                y[j] = (f32x4){bf_lo(w.x), bf_hi(w.x), bf_lo(w.y), bf_hi(w.y)}; ss += (y[j][0] * y[j][0] + y[j][1] * y[j][1]) + (y[j][2] * y[j][2] + y[j][3] * y[j][3]); }
            const float rstd = 1.0f / sqrtf(wave_sum(ss) * (1.0f / D) + EPS);
#pragma unroll
            for (int j = 0; j < 4; ++j) { const f32x4 gt = *(const f32x4*)(gate + (size_t)b * 6144 + 4 * lane + 256 * j); const f32x4 gn = *(const f32x4*)(gny + 4 * lane + 256 * j);
                x[j] = x[j] + gt * (y[j] * rstd * gn); }
        }
        if constexpr (WRITE_X) {
#pragma unroll
            for (int j = 0; j < 4; ++j) *(f32x4*)(xout + (size_t)m * D + 4 * lane + 256 * j) = x[j];
        }
        if constexpr (WRITE_H) {
            float ss = 0.f;
#pragma unroll
            for (int j = 0; j < 4; ++j) ss += (x[j][0] * x[j][0] + x[j][1] * x[j][1]) + (x[j][2] * x[j][2] + x[j][3] * x[j][3]);
            const float rstd = 1.0f / sqrtf(wave_sum(ss) * (1.0f / D) + EPS);
#pragma unroll
            for (int j = 0; j < 4; ++j) { const int col = 4 * lane + 256 * j;
                const f32x4 gn = *(const f32x4*)(gnh + col), s1 = *(const f32x4*)(sc + (size_t)b * 6144 + col), s0 = *(const f32x4*)(sh + (size_t)b * 6144 + col);
                const f32x4 h = (x[j] * rstd * gn) * (1.0f + s1) + s0;
                u32x2 w; w.x = pk2(h[0], h[1]); w.y = pk2(h[2], h[3]); *(u32x2*)(H + (size_t)m * D + col) = w; }
        }
    }
}

constexpr float LOG2E = 1.4426950408889634f, LN2 = 0.6931471805599453f;
constexpr float QSCALE = 0.125f * LOG2E;
template <int NBLK, int UF, class F>
__device__ __forceinline__ void attn_wave(const bf16_t* Z, int pitch, int qcol, int kcol, int vcol, const F& f,
                                          LAS unsigned char* vt, int lane, bf16_t* O, int opitch, int ocol, float* lse_out, int lse_stride) {
    const int q = lane & 31, hi = lane >> 5;
    const int qtok = f.qtok(q);
    bf16x8 qf[4];
    { const bf16_t* qp = Z + (size_t)qtok * pitch + qcol + 8 * hi;
#pragma unroll
      for (int ks = 0; ks < 4; ++ks) qf[ks] = *(const bf16x8*)(qp + 16 * ks); }
    f32x16 o0, o1;
#pragma unroll
    for (int r = 0; r < 16; ++r) { o0[r] = 0.f; o1[r] = 0.f; }
    float m = NEGF, l = 0.f;
    const unsigned tr_addr = (unsigned)(size_t)vt + (unsigned)((4 * hi + ((lane & 15) >> 2)) * 192 + 32 * ((lane >> 4) & 1) + 8 * (lane & 3));
    bf16x8 kf[4]; u32x4 vv[4];
#define ATT_LOADKV(KB, KF, VV) do { const bf16_t* kp_ = Z + (size_t)f.ktok((KB), q) * pitch + kcol + 8 * hi; \
        _Pragma("unroll") for (int ks = 0; ks < 4; ++ks) KF[ks] = *(const bf16x8*)(kp_ + 16 * ks); \
        _Pragma("unroll") for (int i = 0; i < 4; ++i) { const int row_ = (lane >> 3) + 8 * i; VV[i] = *(const u32x4*)(Z + (size_t)f.ktok((KB), row_) * pitch + vcol + 8 * (lane & 7)); } } while (0)
    ATT_LOADKV(0, kf, vv);
#pragma unroll UF
    for (int kb = 0; kb < NBLK; ++kb) {
        bf16x8 kn[4]; u32x4 vn[4];
        if (kb + 1 < NBLK) ATT_LOADKV(kb + 1, kn, vn);
#pragma unroll
        for (int i = 0; i < 4; ++i) { const int row = (lane >> 3) + 8 * i; *(LAS u32x4*)(vt + row * 192 + 16 * (lane & 7)) = vv[i]; }
        f32x16 s;
#pragma unroll
        for (int r = 0; r < 16; ++r) s[r] = 0.f;
#pragma unroll
        for (int ks = 0; ks < 4; ++ks) s = __builtin_amdgcn_mfma_f32_32x32x16_bf16(kf[ks], qf[ks], s, 0, 0, 0);
        const bool masked = f.scores(kb, s, q, hi);
        float mb = s[0];
#pragma unroll
        for (int r = 1; r < 16; ++r) mb = fmaxf(mb, s[r]);
        mb = fmaxf(mb, __shfl_xor(mb, 32));
        if (__any(mb > m + 8.0f)) {
            const float mn = fmaxf(m, mb); const float alpha = __builtin_amdgcn_exp2f(m - mn);
            l *= alpha; m = mn;
#pragma unroll
            for (int r = 0; r < 16; ++r) { o0[r] *= alpha; o1[r] *= alpha; }
        }
        float ps = 0.f;
        if (masked) {
#pragma unroll
            for (int r = 0; r < 16; ++r) { const float e = __builtin_amdgcn_exp2f(s[r] - m); const float p = (s[r] > -1e29f) ? e : 0.f; s[r] = p; ps += p; }
        } else {
#pragma unroll
            for (int r = 0; r < 16; ++r) { const float p = __builtin_amdgcn_exp2f(s[r] - m); s[r] = p; ps += p; }
        }
        ps += __shfl_xor(ps, 32);
        l += ps;
        bf16x8 pf[2];
#pragma unroll
        for (int j = 0; j < 2; ++j) { u32x4 w; w.x = pk2(s[8 * j], s[8 * j + 1]); w.y = pk2(s[8 * j + 2], s[8 * j + 3]); w.z = pk2(s[8 * j + 4], s[8 * j + 5]); w.w = pk2(s[8 * j + 6], s[8 * j + 7]);
            pf[j] = __builtin_bit_cast(bf16x8, w); }
        s16x4 a00, a01, a10, a11, b00, b01, b10, b11;
        asm volatile("s_waitcnt lgkmcnt(0)\n\t"
                     "ds_read_b64_tr_b16 %0, %8 offset:0\n\t"
                     "ds_read_b64_tr_b16 %1, %8 offset:1536\n\t"
                     "ds_read_b64_tr_b16 %2, %8 offset:3072\n\t"
                     "ds_read_b64_tr_b16 %3, %8 offset:4608\n\t"
                     "ds_read_b64_tr_b16 %4, %8 offset:64\n\t"
                     "ds_read_b64_tr_b16 %5, %8 offset:1600\n\t"
                     "ds_read_b64_tr_b16 %6, %8 offset:3136\n\t"
                     "ds_read_b64_tr_b16 %7, %8 offset:4672\n\t"
                     "s_waitcnt lgkmcnt(0)"
                     : "=&v"(a00), "=&v"(a01), "=&v"(a10), "=&v"(a11), "=&v"(b00), "=&v"(b01), "=&v"(b10), "=&v"(b11) : "v"(tr_addr) : "memory");
        const bf16x8 va0 = __builtin_shufflevector(a00, a01, 0, 1, 2, 3, 4, 5, 6, 7), va1 = __builtin_shufflevector(a10, a11, 0, 1, 2, 3, 4, 5, 6, 7);
        const bf16x8 vb0 = __builtin_shufflevector(b00, b01, 0, 1, 2, 3, 4, 5, 6, 7), vb1 = __builtin_shufflevector(b10, b11, 0, 1, 2, 3, 4, 5, 6, 7);
        o0 = __builtin_amdgcn_mfma_f32_32x32x16_bf16(va0, pf[0], o0, 0, 0, 0);
        o0 = __builtin_amdgcn_mfma_f32_32x32x16_bf16(va1, pf[1], o0, 0, 0, 0);
        o1 = __builtin_amdgcn_mfma_f32_32x32x16_bf16(vb0, pf[0], o1, 0, 0, 0);
        o1 = __builtin_amdgcn_mfma_f32_32x32x16_bf16(vb1, pf[1], o1, 0, 0, 0);
        if (kb + 1 < NBLK) {
#pragma unroll
            for (int i = 0; i < 4; ++i) { kf[i] = kn[i]; vv[i] = vn[i]; }
        }
    }
#undef ATT_LOADKV
    const float inv = 1.0f / l;
    bf16_t* op = O + (size_t)qtok * opitch + ocol + 4 * hi;
#pragma unroll
    for (int g4 = 0; g4 < 4; ++g4) {
        u32x2 w0; w0.x = pk2(o0[4 * g4] * inv, o0[4 * g4 + 1] * inv); w0.y = pk2(o0[4 * g4 + 2] * inv, o0[4 * g4 + 3] * inv);
        u32x2 w1; w1.x = pk2(o1[4 * g4] * inv, o1[4 * g4 + 1] * inv); w1.y = pk2(o1[4 * g4 + 2] * inv, o1[4 * g4 + 3] * inv);
        *(u32x2*)(op + 8 * g4) = w0; *(u32x2*)(op + 32 + 8 * g4) = w1;
    }
    if (lse_out != nullptr && hi == 0) lse_out[(size_t)qtok * lse_stride] = (m + __builtin_amdgcn_logf(l)) * LN2;
}

struct DilF {
    int seq0, Ls, dsh, rho, s0; const LAS float* lut; bool edge;
    __device__ __forceinline__ int qtok(int q) const { return seq0 + ((s0 + q) << dsh) + rho; }
    __device__ __forceinline__ int ktok(int kb, int k) const { int sk = s0 - 64 + 32 * kb + k; sk = sk < 0 ? 0 : (sk > Ls - 1 ? Ls - 1 : sk); return seq0 + (sk << dsh) + rho; }
    __device__ __forceinline__ bool scores(int kb, f32x16& s, int q, int hi) const {
        const int bq = 4 * hi - q;
        if (edge) {
#pragma unroll
            for (int r = 0; r < 16; ++r) { const int idx = 32 * kb + (r & 3) + 8 * (r >> 2) + bq, sk = s0 + q + idx - 64;
                const bool valid = (idx >= 0) && (idx <= 128) && (sk >= 0) && (sk < Ls); const int ii = idx < 0 ? 0 : (idx > 128 ? 128 : idx);
                const float bv = lut[ii]; const float t = s[r] * QSCALE + bv; s[r] = valid ? t : NEGF; }
            return true;
        }
        const LAS float* lp = lut + bq + 32 * kb;
        if (kb == 0) {
#pragma unroll
            for (int r = 0; r < 16; ++r) { const int c = (r & 3) + 8 * (r >> 2); const float bv = lp[c]; const float t = s[r] * QSCALE + bv; s[r] = (c + bq >= 0) ? t : NEGF; }
            return true;
        }
        if (kb == 4) {
#pragma unroll
            for (int r = 0; r < 16; ++r) { const int c = (r & 3) + 8 * (r >> 2); const float bv = lp[c]; const float t = s[r] * QSCALE + bv; s[r] = (c + bq <= 0) ? t : NEGF; }
            return true;
        }
#pragma unroll
        for (int r = 0; r < 16; ++r) { const int c = (r & 3) + 8 * (r >> 2); s[r] = s[r] * QSCALE + lp[c]; }
        return false;
    }
};
struct NaF {
    int seq0, r, rs, qh; const LAS float* rpb;
    __device__ __forceinline__ int qtok(int q) const { return seq0 + r * 64 + 32 * qh + q; }
    __device__ __forceinline__ int ktok(int kb, int k) const { const int rp = kb / 3, cg = qh + kb % 3; return seq0 + (rs + 2 * rp + (k >> 4)) * 64 + 16 * cg + (k & 15); }
    __device__ __forceinline__ bool scores(int kb, f32x16& s, int q, int hi) const {
        const int rp = kb / 3, cg = qh + kb % 3, qc = 32 * qh + q; int cs = qc - 8; cs = cs < 0 ? 0 : (cs > 48 ? 48 : cs);
        const int dm = 16 * cg - cs + 4 * hi;
        const LAS float* lp = rpb + (rs + 2 * rp - r + 7) * 31 + 16 * cg - qc + 15 + 4 * hi;
#pragma unroll
        for (int r16 = 0; r16 < 16; ++r16) { const int i2 = r16 >> 3, cr = (r16 & 3) + 8 * ((r16 >> 2) & 1);
            const float bv = lp[i2 * 31 + cr]; const float t = s[r16] * QSCALE + bv; s[r16] = ((unsigned)(dm + cr) < 16u) ? t : NEGF; }
        return true;
    }
};

__device__ __forceinline__ void seq_of(int tok0, int& seq0, int& L) { if (tok0 < TP) { seq0 = tok0 & ~(LP - 1); L = LP; } else { seq0 = TP + ((tok0 - TP) & ~(LSM - 1)); L = LSM; } }

__device__ __forceinline__ void dilated_phase(const Args& a, LAS unsigned char* lds, int tid, int lane, int wave) {
    LAS float* lut = (LAS float*)(lds + 49152);
    for (int i = tid; i < 3 * 8 * 129; i += NTHR) { const int br = i / 1032, rem = i % 1032, h = rem / 129, j = rem % 129; lut[i] = a.in[14][T5B[br][j] * 8 + h] * LOG2E; }
    __syncthreads();
    LAS unsigned char* vt = lds + wave * 6144;
    const bf16_t* Z = (const bf16_t*)(a.ws + WS_Z);
    const int G8 = gridDim.x >> 3, lw = (blockIdx.x >> 3) * NWAVES + wave, NLW = G8 * NWAVES, xh = blockIdx.x & 7;
    constexpr int NTX = (T / 512) * 3 * 16;
    if ((int)blockIdx.x >= G8 * 8) return;
    for (int j = lw; j < NTX; j += NLW) {
        const int i = j & 15; int rest = j >> 4; const int br = rest % 3; const int chunk = rest / 3; const int h = xh;
        int seq0, L; seq_of(chunk * 512, seq0, L);
        const int off = chunk * 512 - seq0, dsh = 2 * br;
        DilF f; f.seq0 = seq0; f.Ls = L >> dsh; f.dsh = dsh; f.rho = i >> (4 - dsh); f.s0 = (off >> dsh) + 32 * (i & ((16 >> dsh) - 1)); f.lut = lut + (br * 8 + h) * 129;
        f.edge = (f.s0 < 64) || (f.s0 + 96 > f.Ls);
        bf16_t* O = (bf16_t*)(a.ws + (br < 2 ? WS_OB01 + (size_t)br * T * 512 * 2 : WS_OB2));
        float* lse = (float*)(a.ws + WS_LSE) + (size_t)br * T * 8 + h;
        attn_wave<5, 5>(Z, EVEN_IN, h * 64, 512 + h * 64, 1024 + h * 64, f, vt, lane, O, 512, h * 64, lse, 8);
    }
}

__device__ __forceinline__ void combine_pool_phase(const Args& a, int lane, int wave) {
    const bf16_t* Z = (const bf16_t*)(a.ws + WS_Z);
    const bf16_t* OB0 = (const bf16_t*)(a.ws + WS_OB01); const bf16_t* OB1 = OB0 + (size_t)T * 512; const bf16_t* OB2 = (const bf16_t*)(a.ws + WS_OB2);
    const float* LSE = (const float*)(a.ws + WS_LSE);
    bf16_t* MX = (bf16_t*)(a.ws + WS_MX);
    const int gw = blockIdx.x * NWAVES + wave, NGW = gridDim.x * NWAVES;
    for (int t = gw; t < T; t += NGW) {
        const int h = lane >> 3;
        const float l0 = LSE[(size_t)t * 8 + h], l1 = LSE[((size_t)T + t) * 8 + h], l2 = LSE[((size_t)2 * T + t) * 8 + h];
        const float mx = fmaxf(l0, fmaxf(l1, l2));
        float w0 = __expf(l0 - mx), w1 = __expf(l1 - mx), w2 = __expf(l2 - mx);
        const float inv = 1.0f / (w0 + w1 + w2); w0 *= inv; w1 *= inv; w2 *= inv;
        const u32x4 a0 = *(const u32x4*)(OB0 + (size_t)t * 512 + 8 * lane), a1 = *(const u32x4*)(OB1 + (size_t)t * 512 + 8 * lane), a2 = *(const u32x4*)(OB2 + (size_t)t * 512 + 8 * lane);
        u32x4 o;
#pragma unroll
        for (int j = 0; j < 4; ++j) { const float lo = w0 * bf_lo(a0[j]) + w1 * bf_lo(a1[j]) + w2 * bf_lo(a2[j]); const float hi = w0 * bf_hi(a0[j]) + w1 * bf_hi(a1[j]) + w2 * bf_hi(a2[j]); o[j] = pk2(lo, hi); }
        *(u32x4*)(MX + (size_t)t * D + 8 * lane) = o;
        int seq0, L; seq_of(t, seq0, L);
        const int tl = t - seq0, half = 1 << (lane >> 4);
        const int lo_t = (tl - half) < 0 ? 0 : (tl - half), hi_t = (tl + half) > L ? L : (tl + half);
        float sum[8];
#pragma unroll
        for (int j = 0; j < 8; ++j) sum[j] = 0.f;
        for (int tt = lo_t; tt < hi_t; ++tt) { const u32x4 u = *(const u32x4*)(Z + (size_t)(seq0 + tt) * EVEN_IN + 1536 + 8 * lane);
#pragma unroll
            for (int j = 0; j < 4; ++j) { sum[2 * j] += bf_lo(u[j]); sum[2 * j + 1] += bf_hi(u[j]); } }
        const float rc = 1.0f / (float)(hi_t - lo_t);
        const u32x4 uc = *(const u32x4*)(Z + (size_t)t * EVEN_IN + 1536 + 8 * lane);
        u32x4 p;
#pragma unroll
        for (int j = 0; j < 4; ++j) p[j] = pk2(sum[2 * j] * rc - bf_lo(uc[j]), sum[2 * j + 1] * rc - bf_hi(uc[j]));
        *(u32x4*)(MX + (size_t)t * D + 512 + 8 * lane) = p;
    }
}

__device__ __forceinline__ void na_phase(const Args& a, LAS unsigned char* lds, int tid, int lane, int wave) {
    LAS float* rpb = (LAS float*)(lds + 49152);
    for (int i = tid; i < 16 * 15 * 31; i += NTHR) rpb[i] = a.in[17][i] * LOG2E;
    __syncthreads();
    LAS unsigned char* vt = lds + wave * 6144;
    const bf16_t* Z = (const bf16_t*)(a.ws + WS_Z);
    bf16_t* MX = (bf16_t*)(a.ws + WS_MX);
    const int G8 = gridDim.x >> 3, lw = (blockIdx.x >> 3) * NWAVES + wave, NLW = G8 * NWAVES, xh = blockIdx.x & 7;
    constexpr int NTX = (T / 32) * 2;
    if ((int)blockIdx.x >= G8 * 8) return;
    for (int j = lw; j < NTX; j += NLW) {
        const int h = 2 * xh + (j & 1), tok0 = (j >> 1) * 32;
        int seq0, L; seq_of(tok0, seq0, L);
        const int off = tok0 - seq0, rows = L >> 6, r = off >> 6;
        int rs = r - 4; rs = rs < 0 ? 0 : (rs > rows - 8 ? rows - 8 : rs);
        NaF f; f.seq0 = seq0; f.r = r; f.rs = rs; f.qh = (off >> 5) & 1; f.rpb = rpb + h * 465;
        attn_wave<12, 1>(Z, QKV, h * 64, 1024 + h * 64, 2048 + h * 64, f, vt, lane, MX, D, h * 64, nullptr, 0);
    }
}

constexpr int NPHASE = 17;
__global__ void __launch_bounds__(NTHR, 2) mega_fwd(Args a) {
    extern __shared__ __attribute__((aligned(16))) unsigned char lds_raw[];
    LAS unsigned char* lds = (LAS unsigned char*)lds_raw;
    const int tid = threadIdx.x, lane = tid & 63, wave = __builtin_amdgcn_readfirstlane(tid >> 6);
    const int G = gridDim.x;
    unsigned char* ws = a.ws;
    float* mod = (float*)(ws + WS_MOD);
    const float* ng = a.in[4];
    bf16_t* H = (bf16_t*)(ws + WS_H); bf16_t* Zb = (bf16_t*)(ws + WS_Z); bf16_t* MX = (bf16_t*)(ws + WS_MX);
    float* out = a.out;
    const int lo = a.ph_lo, hi = a.ph_hi;
#define IN(k) (lo <= (k) && (k) < hi)
#define SEAM(k) do { if (IN(k) && IN((k) + 1)) { cg::this_grid().sync(); } } while (0)
#define MODV(layer, sel) (mod + (size_t)(layer) * NBATCH * 6144 + (sel) * 1024)
#define NGV(layer, sel) (ng + ((layer) * 4 + (sel)) * 1024)
#define GEMM(Ap, Btp, N_, K_, EPI) do { pg8::Gemm g{Ap, Btp, T, N_, K_}; pg8::StaticOrder S; S.init(T, N_, G, (int)blockIdx.x); \
        pg8::gemm_phase<decltype(EPI), pg8::StaticOrder, true, true>(lds, g, S, EPI); } while (0)

    if (IN(0)) { p0_prologue(a, lds, tid, lane, wave); if (PROBE_REP & (1 << 0)) { __syncthreads(); p0_prologue(a, lds, tid, lane, wave); } } SEAM(0);
    if (IN(1)) { norm_pass<false, false, true>(a.in[0], a.in[1], nullptr, nullptr, nullptr, nullptr, H, MODV(0, 0), MODV(0, 1), NGV(0, 0), lane, wave); if (PROBE_REP & (1 << 1)) { __syncthreads(); norm_pass<false, false, true>(a.in[0], a.in[1], nullptr, nullptr, nullptr, nullptr, H, MODV(0, 0), MODV(0, 1), NGV(0, 0), lane, wave); } } SEAM(1);
    if (IN(2)) { pg8::EpiBf16 E{Zb, EVEN_IN}; GEMM(H, (const bf16_t*)(ws + WS_WIN), EVEN_IN, D, E); if (PROBE_REP & (1 << 2)) { __syncthreads(); pg8::EpiBf16 E{Zb, EVEN_IN}; GEMM(H, (const bf16_t*)(ws + WS_WIN), EVEN_IN, D, E); } } SEAM(2);
    if (IN(3)) { dilated_phase(a, lds, tid, lane, wave); if (PROBE_REP & (1 << 3)) { __syncthreads(); dilated_phase(a, lds, tid, lane, wave); } } SEAM(3);
    if (IN(4)) { combine_pool_phase(a, lane, wave); if (PROBE_REP & (1 << 4)) { __syncthreads(); combine_pool_phase(a, lane, wave); } } SEAM(4);
    if (IN(5)) { pg8::EpiBf16 E{H, D}; GEMM(MX, (const bf16_t*)(ws + WS_WOUT0), D, D, E); if (PROBE_REP & (1 << 5)) { __syncthreads(); pg8::EpiBf16 E{H, D}; GEMM(MX, (const bf16_t*)(ws + WS_WOUT0), D, D, E); } } SEAM(5);
    if (IN(6)) { norm_pass<true, true, true>(a.in[0], a.in[1], H, MODV(0, 2), NGV(0, 1), out, H, MODV(0, 3), MODV(0, 4), NGV(0, 2), lane, wave); if (PROBE_REP & (1 << 6)) { __syncthreads(); norm_pass<true, true, true>(a.in[0], a.in[1], H, MODV(0, 2), NGV(0, 1), out, H, MODV(0, 3), MODV(0, 4), NGV(0, 2), lane, wave); } } SEAM(6);
    if (IN(7)) { pg8::EpiSwiglu E{Zb, DFF}; GEMM(H, (const bf16_t*)(ws + WS_WGU), NGU, D, E); if (PROBE_REP & (1 << 7)) { __syncthreads(); pg8::EpiSwiglu E{Zb, DFF}; GEMM(H, (const bf16_t*)(ws + WS_WGU), NGU, D, E); } } SEAM(7);
    if (IN(8)) { pg8::EpiBf16 E{H, D}; GEMM(Zb, (const bf16_t*)(ws + WS_WD), D, DFF, E); if (PROBE_REP & (1 << 8)) { __syncthreads(); pg8::EpiBf16 E{H, D}; GEMM(Zb, (const bf16_t*)(ws + WS_WD), D, DFF, E); } } SEAM(8);
    if (IN(9)) { norm_pass<true, true, true>(out, out + (size_t)TP * D, H, MODV(0, 5), NGV(0, 3), out, H, MODV(1, 0), MODV(1, 1), NGV(1, 0), lane, wave); if (PROBE_REP & (1 << 9)) { __syncthreads(); norm_pass<true, true, true>(out, out + (size_t)TP * D, H, MODV(0, 5), NGV(0, 3), out, H, MODV(1, 0), MODV(1, 1), NGV(1, 0), lane, wave); } } SEAM(9);
    if (IN(10)) { pg8::EpiBf16 E{Zb, QKV}; GEMM(H, (const bf16_t*)(ws + WS_WQKV), QKV, D, E); if (PROBE_REP & (1 << 10)) { __syncthreads(); pg8::EpiBf16 E{Zb, QKV}; GEMM(H, (const bf16_t*)(ws + WS_WQKV), QKV, D, E); } } SEAM(10);
    if (IN(11)) { na_phase(a, lds, tid, lane, wave); if (PROBE_REP & (1 << 11)) { __syncthreads(); na_phase(a, lds, tid, lane, wave); } } SEAM(11);
    if (IN(12)) { pg8::EpiBf16 E{H, D}; GEMM(MX, (const bf16_t*)(ws + WS_WOUT1), D, D, E); if (PROBE_REP & (1 << 12)) { __syncthreads(); pg8::EpiBf16 E{H, D}; GEMM(MX, (const bf16_t*)(ws + WS_WOUT1), D, D, E); } } SEAM(12);
    if (IN(13)) { norm_pass<true, true, true>(out, out + (size_t)TP * D, H, MODV(1, 2), NGV(1, 1), out, H, MODV(1, 3), MODV(1, 4), NGV(1, 2), lane, wave); if (PROBE_REP & (1 << 13)) { __syncthreads(); norm_pass<true, true, true>(out, out + (size_t)TP * D, H, MODV(1, 2), NGV(1, 1), out, H, MODV(1, 3), MODV(1, 4), NGV(1, 2), lane, wave); } } SEAM(13);
    if (IN(14)) { pg8::EpiSwiglu E{Zb, DFF}; GEMM(H, (const bf16_t*)(ws + WS_WGU) + (size_t)NGU * D, NGU, D, E); if (PROBE_REP & (1 << 14)) { __syncthreads(); pg8::EpiSwiglu E{Zb, DFF}; GEMM(H, (const bf16_t*)(ws + WS_WGU) + (size_t)NGU * D, NGU, D, E); } } SEAM(14);
    if (IN(15)) { pg8::EpiBf16 E{H, D}; GEMM(Zb, (const bf16_t*)(ws + WS_WD) + (size_t)D * DFF, D, DFF, E); if (PROBE_REP & (1 << 15)) { __syncthreads(); pg8::EpiBf16 E{H, D}; GEMM(Zb, (const bf16_t*)(ws + WS_WD) + (size_t)D * DFF, D, DFF, E); } } SEAM(15);
    if (IN(16)) { norm_pass<true, true, false>(out, out + (size_t)TP * D, H, MODV(1, 5), NGV(1, 3), out, nullptr, nullptr, nullptr, nullptr, lane, wave); if (PROBE_REP & (1 << 16)) { __syncthreads(); norm_pass<true, true, false>(out, out + (size_t)TP * D, H, MODV(1, 5), NGV(1, 3), out, nullptr, nullptr, nullptr, nullptr, lane, wave); } }
#undef IN
#undef SEAM
}

extern "C" void kernel_launch(void* const* d_in, const int* in_sizes, int n_in, void* d_out, int out_size, void* d_ws, size_t ws_size, hipStream_t stream) {
    static int grid = 0;
    if (grid == 0) {
        if (n_in != 18 || out_size != T * D || ws_size < WS_END) { fprintf(stderr, "kernel_launch: unexpected shapes: n_in %d out %d ws %zu (need %zu)\n", n_in, out_size, ws_size, (size_t)WS_END); grid = -1; return; }
        int dev = 0, cus = 0, per_cu = 0;
        if (hipGetDevice(&dev) != hipSuccess || hipDeviceGetAttribute(&cus, hipDeviceAttributeMultiprocessorCount, dev) != hipSuccess) { grid = -1; return; }
        if (hipFuncSetAttribute((const void*)mega_fwd, hipFuncAttributeMaxDynamicSharedMemorySize, LDS_BYTES) != hipSuccess) { fprintf(stderr, "kernel_launch: hipFuncSetAttribute failed\n"); grid = -1; return; }
        if (hipOccupancyMaxActiveBlocksPerMultiprocessor(&per_cu, (const void*)mega_fwd, NTHR, LDS_BYTES) != hipSuccess || per_cu < 1) { fprintf(stderr, "kernel_launch: occupancy query says %d\n", per_cu); per_cu = 1; }
        (void)hipGetLastError();
        grid = cus * per_cu;
    }
    if (grid < 0) return;
    Args a{};
    for (int i = 0; i < 18; ++i) a.in[i] = (const float*)d_in[i];
    a.out = (float*)d_out; a.ws = (unsigned char*)d_ws;
#if MK_COOP
    a.ph_lo = 0; a.ph_hi = NPHASE;
    void* args[] = {&a};
    hipError_t e = hipLaunchCooperativeKernel((const void*)mega_fwd, dim3(grid), dim3(NTHR), args, LDS_BYTES, stream);
    if (e != hipSuccess) fprintf(stderr, "cooperative launch failed: %s (grid %d)\n", hipGetErrorString(e), grid);
#else
    for (int p = 0; p < NPHASE; ++p) { a.ph_lo = p; a.ph_hi = p + 1; hipLaunchKernelGGL(mega_fwd, dim3(grid), dim3(NTHR), LDS_BYTES, stream, a); }
#endif
}
```
